# Optimizing an MI355X kernel written in HIP

```python
import math
import jax, jax.numpy as jnp
from jax import lax
import numpy as np

D_MODEL = 2048
BATCH = 2
SEQ = 4096
DEPTH = 4
DEC_BATCH = 1
DEC_SEQ = 8192
PAST_LEN = 128

N_EVEN = (DEPTH + 1) // 2
N_ODD = DEPTH // 2
D_FF = 5632
NORM_EPS = 1e-6
HYENA_WIDTH = D_MODEL // 2
LRU_WIDTH = D_MODEL // 2
IN_EVEN = 3 * HYENA_WIDTH + 2 * LRU_WIDTH
HYENA_SHORT = 3
HYENA_EMB = 33
HYENA_BANDS = (HYENA_EMB - 1) // 2
HYENA_FILTER_ORDER = 64
HYENA_INNER = 2
HYENA_TARGET = 1e-2
HYENA_FAST = 0.3
HYENA_SLOW = 1.5
LRU_BLOCKS = 8
LRU_BLOCK = LRU_WIDTH // LRU_BLOCKS
LRU_CONV = 4
LRU_C = 8.0
ATT_HEADS = 16
ATT_HEAD_DIM = D_MODEL // (2 * ATT_HEADS)
ATT_V_DIM = 2 * ATT_HEAD_DIM
Q_BLOCK = 128
ROPE_THETA = 10000.0

kernel_name = "hyena_rglru_diffattn_macaron_encoder"


def _rmsnorm(x, g):
    xf = x.astype(jnp.float32)
    y = xf * lax.rsqrt(jnp.mean(xf * xf, axis=-1, keepdims=True) + NORM_EPS)
    return (y * g.astype(jnp.float32)).astype(x.dtype)


def _swiglu(x, w1, w3, w2):
    return (jax.nn.silu(x @ w1) * (x @ w3)) @ w2


def _depthwise_conv(x, w, b, left):
    K = w.shape[0]
    L = x.shape[1]
    xp = jnp.pad(x, ((0, 0), (left, K - 1 - left), (0, 0)))
    y = b
    for j in range(K):
        y = y + xp[:, j:j + L] * w[j]
    return y


def _hyena_filter(L, w_in, b, w_hid, freq, w_out):
    f32 = jnp.float32
    pos = jnp.arange(L, dtype=f32)[:, None]
    t = pos / max(L - 1, 1)
    w = (2.0 * math.pi / L) * pos
    bands = jnp.linspace(1e-4, HYENA_BANDS - 1, HYENA_BANDS, dtype=f32)[None, :]
    z = jnp.concatenate([t, jnp.cos(bands * w), -jnp.sin(bands * w)], axis=-1)
    fr = freq.astype(f32)
    h = jnp.sin(fr * (z @ w_in.astype(f32) + b[0].astype(f32)))
    for j in range(HYENA_INNER):
        h = jnp.sin(fr * (h @ w_hid[j].astype(f32) + b[j + 1].astype(f32)))
    k = (h @ w_out.astype(f32)).reshape(L, 2, HYENA_WIDTH)
    deltas = jnp.abs(jnp.linspace(math.log(HYENA_TARGET) / HYENA_SLOW,
                                  math.log(HYENA_TARGET) / HYENA_FAST, HYENA_WIDTH, dtype=f32))
    decay = jnp.exp(-t * deltas[None, :])
    k = k * decay[:, None, :]
    return jnp.concatenate([k[:, 0], jnp.zeros((1, HYENA_WIDTH), f32), jnp.flip(k[1:, 1], axis=0)], axis=0)


def _fft_long_conv(u, k_two, bias):
    L = u.shape[1]
    uf = u.astype(jnp.float32)
    U = jnp.fft.rfft(uf, n=2 * L, axis=1)
    Kf = jnp.fft.rfft(k_two, n=2 * L, axis=0)
    y = jnp.fft.irfft(U * Kf[None], n=2 * L, axis=1)[:, :L]
    return (y + uf * bias.astype(jnp.float32)).astype(u.dtype)


def _hyena(p, conv_w, conv_b, f_w_in, f_b, f_w_hid, f_freq, f_w_out, h_bias):
    L = p.shape[1]
    uc = _depthwise_conv(p, conv_w, conv_b, (HYENA_SHORT - 1) // 2)
    x0 = uc[..., :HYENA_WIDTH]
    x1 = uc[..., HYENA_WIDTH:2 * HYENA_WIDTH]
    v = uc[..., 2 * HYENA_WIDTH:]
    k_two = _hyena_filter(L, f_w_in, f_b, f_w_hid, f_freq, f_w_out)
    return x0 * _fft_long_conv(v * x1, k_two, h_bias)


def _lin_combine(e1, e2):
    a1, b1 = e1
    a2, b2 = e2
    return a1 * a2, a2 * b1 + b2


def _rg_lru_direction(xb, wa, ba, wx, bx, lam, reverse):
    B, L, W = xb.shape
    f32 = jnp.float32
    xf = xb.astype(f32)
    xr = xf.reshape(B, L, LRU_BLOCKS, LRU_BLOCK)
    r = jax.nn.sigmoid(jnp.einsum('blnc,ncd->blnd', xr, wa.astype(f32)).reshape(B, L, W) + ba.astype(f32))
    i = jax.nn.sigmoid(jnp.einsum('blnc,ncd->blnd', xr, wx.astype(f32)).reshape(B, L, W) + bx.astype(f32))
    log_a = -LRU_C * r * jax.nn.softplus(-lam.astype(f32))
    a = jnp.exp(log_a)
    b = jnp.sqrt(-jnp.expm1(2.0 * log_a)) * (i * xf)
    _, h = lax.associative_scan(_lin_combine, (a, b), reverse=reverse, axis=1)
    return h


def _rg_lru_block(pg, pl, conv_w, conv_b, wa, ba, wx, bx, lam):
    gate = jax.nn.gelu(pg)
    xb = _depthwise_conv(pl, conv_w, conv_b, LRU_CONV // 2)
    h = (_rg_lru_direction(xb, wa[0], ba[0], wx[0], bx[0], lam[0], False)
         + _rg_lru_direction(xb, wa[1], ba[1], wx[1], bx[1], lam[1], True))
    return h.astype(pg.dtype) * gate


def _rope(L, dim, dtype):
    inv = ROPE_THETA ** (-jnp.arange(0, dim, 2, dtype=jnp.float32) / dim)
    ang = jnp.arange(L, dtype=jnp.float32)[:, None] * inv[None, :]
    ang = jnp.concatenate([ang, ang], axis=-1)
    return jnp.cos(ang).astype(dtype), jnp.sin(ang).astype(dtype)


def _apply_rope(x, cos, sin):
    half = x.shape[-1] // 2
    rot = jnp.concatenate([-x[..., half:], x[..., :half]], axis=-1)
    return x * cos + rot * sin


def _diff_attention(x, w_qkv, lam_vec, subln_g, w_o, lambda_init):
    B, L, _ = x.shape
    qkv = x @ w_qkv
    q = qkv[..., :D_MODEL].reshape(B, L, ATT_HEADS, 2, ATT_HEAD_DIM)
    k = qkv[..., D_MODEL:2 * D_MODEL].reshape(B, L, ATT_HEADS, 2, ATT_HEAD_DIM)
    v = qkv[..., 2 * D_MODEL:].reshape(B, L, ATT_HEADS, ATT_V_DIM)
    cos, sin = _rope(L, ATT_HEAD_DIM, x.dtype)
    cos = cos[None, :, None, None, :]
    sin = sin[None, :, None, None, :]
    q = _apply_rope(q, cos, sin) * (ATT_HEAD_DIM ** -0.5)
    k = _apply_rope(k, cos, sin)
    lv = lam_vec.astype(jnp.float32)
    lam = jnp.exp(jnp.sum(lv[0] * lv[1])) - jnp.exp(jnp.sum(lv[2] * lv[3])) + lambda_init
    nb = L // Q_BLOCK
    qb = jnp.moveaxis(q.reshape(B, nb, Q_BLOCK, ATT_HEADS, 2, ATT_HEAD_DIM), 1, 0)

    def block(qblk):
        s = jnp.einsum('bqhcd,bkhcd->bhcqk', qblk, k).astype(jnp.float32)
        p = jax.nn.softmax(s, axis=-1)
        a = p[:, :, 0] - lam * p[:, :, 1]
        return jnp.einsum('bhqk,bkhe->bqhe', a.astype(v.dtype), v)

    o = jnp.moveaxis(lax.map(block, qb), 0, 1).reshape(B, L, ATT_HEADS, ATT_V_DIM)
    o = _rmsnorm(o, subln_g) * (1.0 - lambda_init)
    return o.reshape(B, L, ATT_HEADS * ATT_V_DIM) @ w_o


def _trunk(x, ffn_norm, ffn_w1, ffn_w3, ffn_w2, mix_norm, final_norm,
           even_w_in, hyena_conv_w, hyena_conv_b, hyena_filt_w_in, hyena_filt_b, hyena_filt_w_hid,
           hyena_filt_freq, hyena_filt_w_out, hyena_bias, lru_conv_w, lru_conv_b, lru_wa, lru_ba,
           lru_wx, lru_bx, lru_lambda, even_w_out, attn_w_qkv, attn_lambda, attn_subln, attn_w_o):
    for i in range(DEPTH):
        x = x + 0.5 * _swiglu(_rmsnorm(x, ffn_norm[i, 0]), ffn_w1[i, 0], ffn_w3[i, 0], ffn_w2[i, 0])
        h = _rmsnorm(x, mix_norm[i])
        j = i // 2
        if i % 2 == 0:
            p = h @ even_w_in[j]
            ph = p[..., :3 * HYENA_WIDTH]
            pg = p[..., 3 * HYENA_WIDTH:3 * HYENA_WIDTH + LRU_WIDTH]
            pl = p[..., 3 * HYENA_WIDTH + LRU_WIDTH:]
            yh = _hyena(ph, hyena_conv_w[j], hyena_conv_b[j], hyena_filt_w_in[j], hyena_filt_b[j],
                        hyena_filt_w_hid[j], hyena_filt_freq[j], hyena_filt_w_out[j], hyena_bias[j])
            yl = _rg_lru_block(pg, pl, lru_conv_w[j], lru_conv_b[j], lru_wa[j], lru_ba[j],
                               lru_wx[j], lru_bx[j], lru_lambda[j])
            x = x + jnp.concatenate([yh, yl], axis=-1) @ even_w_out[j]
        else:
            lambda_init = 0.8 - 0.6 * math.exp(-0.3 * i)
            x = x + _diff_attention(h, attn_w_qkv[j], attn_lambda[j], attn_subln[j], attn_w_o[j], lambda_init)
        x = x + 0.5 * _swiglu(_rmsnorm(x, ffn_norm[i, 1]), ffn_w1[i, 1], ffn_w3[i, 1], ffn_w2[i, 1])
    return _rmsnorm(x, final_norm)


def setup_inputs(seed: int = 0) -> dict:
    key = jax.random.key(seed)
    ks = jax.random.split(key, 32)
    f32 = jnp.float32

    def nrm(k, shape, scale):
        return jax.random.normal(k, shape, f32) * scale

    def gain(k, shape):
        return 1.0 + 0.05 * jax.random.normal(k, shape, f32)

    u = jax.random.uniform(ks[22], (N_EVEN, 2, LRU_WIDTH), f32, 0.9, 0.999)
    a0 = u ** (1.0 / LRU_C)
    lru_lambda = jnp.log(a0) - jnp.log1p(-a0)
    return {
        "x_prompt": nrm(ks[0], (BATCH, SEQ, D_MODEL), 1.0),
        "x_sample": nrm(ks[1], (DEC_BATCH, DEC_SEQ, D_MODEL), 1.0),
        "ffn_norm": gain(ks[2], (DEPTH, 2, D_MODEL)),
        "ffn_w1": nrm(ks[3], (DEPTH, 2, D_MODEL, D_FF), D_MODEL ** -0.5),
        "ffn_w3": nrm(ks[4], (DEPTH, 2, D_MODEL, D_FF), D_MODEL ** -0.5),
        "ffn_w2": nrm(ks[5], (DEPTH, 2, D_FF, D_MODEL), D_FF ** -0.5),
        "mix_norm": gain(ks[6], (DEPTH, D_MODEL)),
        "final_norm": gain(ks[7], (D_MODEL,)),
        "even_w_in": nrm(ks[8], (N_EVEN, D_MODEL, IN_EVEN), D_MODEL ** -0.5),
        "hyena_conv_w": nrm(ks[9], (N_EVEN, HYENA_SHORT, 3 * HYENA_WIDTH), HYENA_SHORT ** -0.5),
        "hyena_conv_b": nrm(ks[10], (N_EVEN, 3 * HYENA_WIDTH), 0.02),
        "hyena_filt_w_in": nrm(ks[11], (N_EVEN, HYENA_EMB, HYENA_FILTER_ORDER), HYENA_EMB ** -0.5),
        "hyena_filt_b": nrm(ks[12], (N_EVEN, HYENA_INNER + 1, HYENA_FILTER_ORDER), 0.1),
        "hyena_filt_w_hid": nrm(ks[13], (N_EVEN, HYENA_INNER, HYENA_FILTER_ORDER, HYENA_FILTER_ORDER), HYENA_FILTER_ORDER ** -0.5),
        "hyena_filt_freq": gain(ks[14], (N_EVEN, HYENA_FILTER_ORDER)),
        "hyena_filt_w_out": nrm(ks[15], (N_EVEN, HYENA_FILTER_ORDER, 2 * HYENA_WIDTH), 0.1 * HYENA_FILTER_ORDER ** -0.5),
        "hyena_bias": nrm(ks[16], (N_EVEN, HYENA_WIDTH), 0.5),
        "lru_conv_w": nrm(ks[17], (N_EVEN, LRU_CONV, LRU_WIDTH), LRU_CONV ** -0.5),
        "lru_conv_b": nrm(ks[18], (N_EVEN, LRU_WIDTH), 0.02),
        "lru_wa": nrm(ks[19], (N_EVEN, 2, LRU_BLOCKS, LRU_BLOCK, LRU_BLOCK), LRU_BLOCK ** -0.5),
        "lru_ba": nrm(ks[20], (N_EVEN, 2, LRU_WIDTH), 0.02),
        "lru_wx": nrm(ks[21], (N_EVEN, 2, LRU_BLOCKS, LRU_BLOCK, LRU_BLOCK), LRU_BLOCK ** -0.5),
        "lru_bx": nrm(ks[23], (N_EVEN, 2, LRU_WIDTH), 0.02),
        "lru_lambda": lru_lambda,
        "even_w_out": nrm(ks[24], (N_EVEN, HYENA_WIDTH + LRU_WIDTH, D_MODEL), (HYENA_WIDTH + LRU_WIDTH) ** -0.5),
        "attn_w_qkv": nrm(ks[25], (N_ODD, D_MODEL, 3 * D_MODEL), D_MODEL ** -0.5),
        "attn_lambda": nrm(ks[26], (N_ODD, 4, ATT_HEAD_DIM), 0.1),
        "attn_subln": gain(ks[27], (N_ODD, ATT_V_DIM)),
        "attn_w_o": nrm(ks[28], (N_ODD, D_MODEL, D_MODEL), D_MODEL ** -0.5),
    }


def reference(x_prompt, x_sample, ffn_norm, ffn_w1, ffn_w3, ffn_w2, mix_norm, final_norm,
              even_w_in, hyena_conv_w, hyena_conv_b, hyena_filt_w_in, hyena_filt_b, hyena_filt_w_hid,
              hyena_filt_freq, hyena_filt_w_out, hyena_bias, lru_conv_w, lru_conv_b, lru_wa, lru_ba,
              lru_wx, lru_bx, lru_lambda, even_w_out, attn_w_qkv, attn_lambda, attn_subln, attn_w_o):
    y_prompt = _trunk(x_prompt, ffn_norm, ffn_w1, ffn_w3, ffn_w2, mix_norm, final_norm,
                      even_w_in, hyena_conv_w, hyena_conv_b, hyena_filt_w_in, hyena_filt_b, hyena_filt_w_hid,
                      hyena_filt_freq, hyena_filt_w_out, hyena_bias, lru_conv_w, lru_conv_b, lru_wa, lru_ba,
                      lru_wx, lru_bx, lru_lambda, even_w_out, attn_w_qkv, attn_lambda, attn_subln, attn_w_o)
    y_sample = _trunk(x_sample, ffn_norm, ffn_w1, ffn_w3, ffn_w2, mix_norm, final_norm,
                      even_w_in, hyena_conv_w, hyena_conv_b, hyena_filt_w_in, hyena_filt_b, hyena_filt_w_hid,
                      hyena_filt_freq, hyena_filt_w_out, hyena_bias, lru_conv_w, lru_conv_b, lru_wa, lru_ba,
                      lru_wx, lru_bx, lru_lambda, even_w_out, attn_w_qkv, attn_lambda, attn_subln, attn_w_o)
    return (y_prompt, y_sample)
```

```cpp
#ifdef CPU_TEST
#include <cmath>
#include <cstdint>
#include <cstddef>
#define HD inline
#else
#include <hip/hip_runtime.h>
#include <cstdio>
#include <cstdint>
#define HD __host__ __device__ __forceinline__
#endif

#if defined(CFG_SMALL)
constexpr int D_MODEL = 256, BATCH = 2, SEQ = 64, DEPTH = 4, DEC_SEQ = 128, D_FF = 512, ATT_HEADS = 2;
#elif defined(CFG_EMU)
constexpr int D_MODEL = 256, BATCH = 2, SEQ = 128, DEPTH = 4, DEC_SEQ = 256, D_FF = 512, ATT_HEADS = 2;
#else
constexpr int D_MODEL = 2048, BATCH = 2, SEQ = 4096, DEPTH = 4, DEC_SEQ = 8192, D_FF = 5632, ATT_HEADS = 16;
#endif
constexpr int M = BATCH * SEQ + DEC_SEQ;
constexpr int N_EVEN = (DEPTH + 1) / 2, N_ODD = DEPTH / 2;
constexpr int HW = D_MODEL / 2, LW = D_MODEL / 2, IN_EVEN = 3 * HW + 2 * LW;
constexpr int FO = 64, EMB = 33, BANDS = 16;
constexpr int LRU_BLOCKS = 8, LB = LW / LRU_BLOCKS;
constexpr int DH = D_MODEL / (2 * ATT_HEADS), DV = 2 * DH;
constexpr int QKV_N = 3 * D_MODEL, UP_N = 2 * D_FF;
constexpr float NORM_EPS = 1e-6f;
constexpr int FILT_T = SEQ + DEC_SEQ;

#if defined(CPU_TEST) && defined(NO_BF16)
typedef float bf16;
HD float f2bf(float f) { return f; }
HD float bf2f(float b) { return b; }
#else
typedef unsigned short bf16;
HD unsigned f2bf(float f) { unsigned u; __builtin_memcpy(&u, &f, 4); return (u + 0x7fffu + ((u >> 16) & 1u)) >> 16; }
HD float bf2f(unsigned b) { unsigned u = b << 16; float f; __builtin_memcpy(&f, &u, 4); return f; }
#endif

struct SeqInfo { int row0, len; };
HD SeqInfo seq_of_row(int m) { SeqInfo s; if (m < BATCH * SEQ) { s.row0 = (m / SEQ) * SEQ; s.len = SEQ; } else { s.row0 = BATCH * SEQ; s.len = DEC_SEQ; } return s; }
HD float sigmoidf_(float x) { return 1.0f / (1.0f + expf(-x)); }
HD float softplusf_(float x) { return x > 20.f ? x : log1pf(expf(x)); }
HD float gelu_tanhf_(float x) { return 0.5f * x * (1.0f + tanhf(0.7978845608028654f * (x + 0.044715f * x * x * x))); }
HD float lambda_init_of(int layer) { return 0.8f - 0.6f * expf(-0.3f * (float)layer); }

HD void filt_pos(int tt, int& L, int& pos) { if (tt < SEQ) { L = SEQ; pos = tt; } else { L = DEC_SEQ; pos = tt - SEQ; } }
HD float el_filt_h0(const float* w_in  , const float* b  , const float* freq  , int tt, int q) {
    int L, pos; filt_pos(tt, L, pos);
    const float fp = (float)pos, tn = fp / (float)(L - 1 > 1 ? L - 1 : 1), w = (6.283185307179586f / (float)L) * fp;
    float acc = b[q] + tn * w_in[q];
    for (int e = 0; e < BANDS; ++e) { const float band = 1e-4f + (float)e * ((float)(BANDS - 1) - 1e-4f) / (float)(BANDS - 1);
        acc += cosf(band * w) * w_in[(1 + e) * FO + q] - sinf(band * w) * w_in[(1 + BANDS + e) * FO + q]; }
    return sinf(freq[q] * acc);
}
HD float el_filt_hid(const float* hprev_row  , const float* w_hid  , const float* bias  , const float* freq, int q) {
    float acc = bias[q];
    for (int r = 0; r < FO; ++r) acc += hprev_row[r] * w_hid[r * FO + q];
    return sinf(freq[q] * acc);
}
HD float el_filt_out(const float* h2_row, const float* w_out  , int tt, int dir, int c) {
    int L, pos; filt_pos(tt, L, pos);
    const float tn = (float)pos / (float)(L - 1 > 1 ? L - 1 : 1);
    const float la = -4.605170185988091f / 1.5f, lb = -4.605170185988091f / 0.3f;
    const float delta = fabsf(la + (lb - la) * (float)c / (float)(HW - 1));
    float acc = 0.f;
    for (int q = 0; q < FO; ++q) acc += h2_row[q] * w_out[q * (2 * HW) + dir * HW + c];
    return acc * expf(-tn * delta);
}

HD void el_hyena_pre(const bf16* p  , const float* cw  , const float* cb  , int m, int c, float& u, float& x0) {
    const SeqInfo s = seq_of_row(m); const int t = m - s.row0; float r[3];
    for (int k = 0; k < 3; ++k) { const int col = k * HW + c; float acc = cb[col];
        for (int j = 0; j < 3; ++j) { const int tt = t + j - 1; if (tt >= 0 && tt < s.len) acc += bf2f(p[(size_t)(s.row0 + tt) * IN_EVEN + col]) * cw[j * (3 * HW) + col]; }
        r[k] = acc; }
    x0 = r[0]; u = r[2] * r[1];
}
HD void el_hyena_conv8(const float* u  , const float* x0, const float* kf  , const float* kb, const float* hbias, int m0, int c, float (&y)[8]) {
    const SeqInfo s = seq_of_row(m0); const int t0 = m0 - s.row0; const int base = (s.len == SEQ) ? 0 : SEQ;
    float acc[8];
#pragma unroll
    for (int i = 0; i < 8; ++i) acc[i] = 0.f;
    for (int s0 = 0; s0 < s.len; s0 += 8) {
        float uu[8], kk[15];
#pragma unroll
        for (int j = 0; j < 8; ++j) uu[j] = u[(size_t)(s.row0 + s0 + j) * HW + c];
#pragma unroll
        for (int e = 0; e < 15; ++e) { const int d = t0 - s0 - 7 + e; kk[e] = d >= 0 ? kf[(size_t)(base + d) * HW + c] : kb[(size_t)(base - d) * HW + c]; }
#pragma unroll
        for (int i = 0; i < 8; ++i)
#pragma unroll
            for (int j = 0; j < 8; ++j) acc[i] += uu[j] * kk[i - j + 7];
    }
#pragma unroll
    for (int i = 0; i < 8; ++i) y[i] = x0[(size_t)(m0 + i) * HW + c] * (acc[i] + hbias[c] * u[(size_t)(m0 + i) * HW + c]);
}

HD float el_lru_pre(const bf16* p, const float* cw  , const float* cb, int m, int c) {
    const SeqInfo s = seq_of_row(m); const int t = m - s.row0; float acc = cb[c];
    for (int j = 0; j < 4; ++j) { const int tt = t + j - 2; if (tt >= 0 && tt < s.len) acc += bf2f(p[(size_t)(s.row0 + tt) * IN_EVEN + 3 * HW + LW + c]) * cw[j * LW + c]; }
    return acc;
}
HD void el_lru_gate(const float* xb  , const float* wa  , const float* ba  , const float* wx, const float* bx, const float* lam, int m, int c, float& a, float& b) {
    const int n = c / LB, d = c % LB; float sa = ba[c], sx = bx[c];
    const float* xr = xb + (size_t)m * LW + n * LB;
    for (int cc = 0; cc < LB; ++cc) { const float xv = xr[cc]; sa += xv * wa[((size_t)n * LB + cc) * LB + d]; sx += xv * wx[((size_t)n * LB + cc) * LB + d]; }
    const float r = sigmoidf_(sa), i = sigmoidf_(sx);
    const float log_a = -8.0f * r * softplusf_(-lam[c]);
    a = expf(log_a); b = sqrtf(-expm1f(2.0f * log_a)) * (i * xb[(size_t)m * LW + c]);
}
HD void el_lru_scan(const float* __restrict__ a, const float* __restrict__ b  , float* __restrict__ h, int seq, int c, int reverse) {
    const int row0 = seq < BATCH ? seq * SEQ : BATCH * SEQ, len = seq < BATCH ? SEQ : DEC_SEQ; float s = 0.f;
    for (int tb = 0; tb < len; tb += 8) {
        float aa[8], bb[8];
#pragma unroll
        for (int k = 0; k < 8; ++k) { const int t = reverse ? len - 1 - (tb + k) : tb + k; const size_t i = (size_t)(row0 + t) * LW + c; aa[k] = a[i]; bb[k] = b[i]; }
#pragma unroll
        for (int k = 0; k < 8; ++k) { const int t = reverse ? len - 1 - (tb + k) : tb + k; const size_t i = (size_t)(row0 + t) * LW + c; s = aa[k] * s + bb[k]; h[i] = s; }
    }
}
HD float el_lru_out(const bf16* p, const float* hf, const float* hb, int m, int c) {
    return (hf[(size_t)m * LW + c] + hb[(size_t)m * LW + c]) * gelu_tanhf_(bf2f(p[(size_t)m * IN_EVEN + 3 * HW + c]));
}

HD void el_rope(bf16* qkv, int m, int which, int sh, int d, float qscale) {
    const SeqInfo s = seq_of_row(m); const int t = m - s.row0;
    const float inv = powf(10000.0f, -(float)(2 * d) / (float)DH), ang = (float)t * inv, cs = cosf(ang), sn = sinf(ang);
    bf16* x = qkv + (size_t)m * QKV_N + which * D_MODEL + sh * DH;
    const float lo = bf2f(x[d]), hi = bf2f(x[d + DH / 2]); const float sc = which == 0 ? qscale : 1.0f;
    x[d] = (bf16)f2bf((lo * cs - hi * sn) * sc); x[d + DH / 2] = (bf16)f2bf((hi * cs + lo * sn) * sc);
}
HD float attn_lambda_of(const float* lv  , int layer) { float s0 = 0.f, s1 = 0.f; for (int d = 0; d < DH; ++d) { s0 += lv[d] * lv[DH + d]; s1 += lv[2 * DH + d] * lv[3 * DH + d]; } return expf(s0) - expf(s1) + lambda_init_of(layer); }
HD void el_attn(const bf16* qkv, float* oc  , int m, int h, int comp, int row0, int len) {
    float q[DH], acc[DV];
    const bf16* qp = qkv + (size_t)m * QKV_N + (h * 2 + comp) * DH;
#pragma unroll
    for (int d = 0; d < DH; ++d) q[d] = bf2f(qp[d]);
#pragma unroll
    for (int e = 0; e < DV; ++e) acc[e] = 0.f;
    float mx = -INFINITY, l = 0.f;
    const bf16* kp = qkv + (size_t)row0 * QKV_N + D_MODEL + (h * 2 + comp) * DH;
    const bf16* vp = qkv + (size_t)row0 * QKV_N + 2 * D_MODEL + h * DV;
    for (int key = 0; key < len; ++key, kp += QKV_N, vp += QKV_N) {
        float sc = 0.f;
#pragma unroll
        for (int d = 0; d < DH; ++d) sc += q[d] * bf2f(kp[d]);
        if (sc > mx) { const float f = expf(mx - sc); l *= f;
#pragma unroll
            for (int e = 0; e < DV; ++e) acc[e] *= f;
            mx = sc; }
        const float pr = expf(sc - mx); l += pr;
#pragma unroll
        for (int e = 0; e < DV; ++e) acc[e] += pr * bf2f(vp[e]);
    }
    const float il = 1.0f / l; float* o = oc + (((size_t)comp * M + m) * ATT_HEADS + h) * DV;
#pragma unroll
    for (int e = 0; e < DV; ++e) o[e] = acc[e] * il;
}
HD void el_attn_fin(const float* oc, const float* subln  , float lam, float one_minus_li, bf16* y  , int m, int h) {
    const float* o0 = oc + (((size_t)0 * M + m) * ATT_HEADS + h) * DV; const float* o1 = oc + (((size_t)1 * M + m) * ATT_HEADS + h) * DV;
    float ss = 0.f;
    for (int e = 0; e < DV; ++e) { const float v = o0[e] - lam * o1[e]; ss += v * v; }
    const float rs = 1.0f / sqrtf(ss / (float)DV + NORM_EPS);
    for (int e = 0; e < DV; ++e) { const float v = o0[e] - lam * o1[e]; y[(size_t)m * D_MODEL + h * DV + e] = (bf16)f2bf(v * rs * subln[e] * one_minus_li); }
}
HD float silu_mul(float h1, float h3) { return h1 / (1.0f + expf(-h1)) * h3; }
HD void up_row_src(int n, int& which, int& col) { which = (n % 256) / 128; col = 128 * (n / 256) + (n % 128); }
HD int qkv_row_src(int n) { const int pn = n / 256; if (pn >= 2 * D_MODEL / 256) return n; const int bj = (n % 256) / 128, jj = n % 128; return (pn * 4 + jj / 32) * DH + bj * (DH / 2) + (jj % 32); }

#ifndef CPU_TEST
namespace pg8 {
#define PG8_LAS __attribute__((address_space(3)))
typedef unsigned short bf16_t;
typedef short bf16x8 __attribute__((ext_vector_type(8)));
typedef float f32x4 __attribute__((ext_vector_type(4)));
typedef unsigned u32x4 __attribute__((ext_vector_type(4)));
constexpr int BM = 256, BK = 64, HALF = 128, HTB = HALF * BK * 2  , STAGE_BYTES = 8 * HTB, NXCD = 8, WGM = 8;

__host__ __device__ __forceinline__ int lds_byte(int r, int c) { const int st = (r >> 4) * 2 + (c >> 5), rr = r & 15, cc = c & 31, ob = rr * 64 + cc * 2; return st * 1024 + (ob ^ (((ob >> 9) & 1) << 5)); }
__host__ __device__ __forceinline__ void stage_rc(int b, int& R, int& C) { const int st = b / 1024, sb = b % 1024, swz = sb ^ (((sb >> 9) & 1) << 5); R = (st >> 1) * 16 + swz / 64; C = (st & 1) * 32 + (swz % 64) / 2; }
__host__ __device__ __forceinline__ int perm32(int rho) { const int n = rho >> 4, i = rho & 15; return 8 * (i >> 2) + 4 * n + (i & 3); }

struct Unit { int pm, pn; };
struct Gemm { const bf16_t* A; const bf16_t* Bt; int M, N, K; };

struct StaticOrder {
    int nM, nN, nwg, G, c;
    __host__ __device__ void init(int M, int N, int G_, int c_) { nM = M / BM; nN = N / BM; nwg = nM * nN; G = G_; c = c_; }
    __host__ __device__ bool next(int i, Unit& u) const {
        const long L = (long)i * G + c; if (L >= nwg) return false;
        int wgid = (int)L; { const int q = nwg / NXCD, r = nwg % NXCD, xcd = wgid % NXCD, off = wgid / NXCD; wgid = (xcd < r ? xcd * (q + 1) : r * (q + 1) + (xcd - r) * q) + off; }
        const int nig = WGM * nN, gid = wgid / nig, fm = gid * WGM, gsz = (nM - fm) < WGM ? (nM - fm) : WGM;
        u.pm = fm + ((wgid % nig) % gsz); u.pn = (wgid % nig) / gsz; return true;
    }
    __device__ __forceinline__ void a_ready(const Unit&) const {}
    __device__ __forceinline__ void done(const Unit&) const {}
};
__device__ __forceinline__ unsigned cvt_pk_bf16(float lo, float hi) { unsigned r; asm volatile("v_cvt_pk_bf16_f32 %0, %1, %2" : "=v"(r) : "v"(lo), "v"(hi)); return r; }
typedef float f32x2 __attribute__((ext_vector_type(2)));
struct EpiBf16Plain {
    static constexpr bool PERM = true, AFTER_DRAIN = false;
    bf16_t* O; int ldc;
    __device__ __forceinline__ void operator()(const f32x4 (&acc)[2][2][4][2], const Unit& u, int wr, int wc, int fr, int fq) const {
        const int row0 = u.pm * BM + wr * 64 + fr, col0 = u.pn * BM + wc * 32 + 8 * fq;
#pragma unroll
        for (int ai = 0; ai < 2; ++ai)
#pragma unroll
            for (int m = 0; m < 4; ++m) { bf16_t* rowp = O + (size_t)(row0 + ai * HALF + m * 16) * ldc + col0;
#pragma unroll
                for (int bj = 0; bj < 2; ++bj) { const f32x4 v0 = acc[ai][bj][m][0], v1 = acc[ai][bj][m][1];
                    u32x4 w; w.x = cvt_pk_bf16(v0[0], v0[1]); w.y = cvt_pk_bf16(v0[2], v0[3]); w.z = cvt_pk_bf16(v1[0], v1[1]); w.w = cvt_pk_bf16(v1[2], v1[3]);
                    *(u32x4*)(rowp + bj * HALF) = w; } }
    }
};
__device__ __forceinline__ float silu_mul_fast(float h1, float h3) { return h1 * __builtin_amdgcn_rcpf(1.0f + __builtin_amdgcn_exp2f(-1.4426950408889634f * h1)) * h3; }
struct EpiSwiGLU {
    static constexpr bool PERM = true, AFTER_DRAIN = false;
    bf16_t* O; int ldc;
    __device__ __forceinline__ void operator()(const f32x4 (&acc)[2][2][4][2], const Unit& u, int wr, int wc, int fr, int fq) const {
        const int row0 = u.pm * BM + wr * 64 + fr, col0 = u.pn * HALF + wc * 32 + 8 * fq;
#pragma unroll
        for (int ai = 0; ai < 2; ++ai)
#pragma unroll
            for (int m = 0; m < 4; ++m) { bf16_t* rowp = O + (size_t)(row0 + ai * HALF + m * 16) * ldc + col0;
                float g[8];
#pragma unroll
                for (int n = 0; n < 2; ++n)
#pragma unroll
                    for (int j = 0; j < 4; ++j) g[4 * n + j] = silu_mul_fast(acc[ai][0][m][n][j], acc[ai][1][m][n][j]);
                u32x4 w; w.x = cvt_pk_bf16(g[0], g[1]); w.y = cvt_pk_bf16(g[2], g[3]); w.z = cvt_pk_bf16(g[4], g[5]); w.w = cvt_pk_bf16(g[6], g[7]);
                *(u32x4*)rowp = w; }
    }
};
struct EpiResid {
    static constexpr bool PERM = false, AFTER_DRAIN = false;
    float* X; int ldc; float scale;
    __device__ __forceinline__ void operator()(const f32x4 (&acc)[2][2][4][2], const Unit& u, int wr, int wc, int fr, int fq) const {
        const int row0 = u.pm * BM + wr * 64 + fr, col0 = u.pn * BM + wc * 32 + 4 * fq;
#pragma unroll
        for (int ai = 0; ai < 2; ++ai)
#pragma unroll
            for (int m = 0; m < 4; ++m) { float* rowp = X + (size_t)(row0 + ai * HALF + m * 16) * ldc + col0;
                f32x4 old[2][2];
#pragma unroll
                for (int bj = 0; bj < 2; ++bj)
#pragma unroll
                    for (int n = 0; n < 2; ++n) old[bj][n] = *(const f32x4*)(rowp + bj * HALF + n * 16);
#pragma unroll
                for (int bj = 0; bj < 2; ++bj)
#pragma unroll
                    for (int n = 0; n < 2; ++n) *(f32x4*)(rowp + bj * HALF + n * 16) = old[bj][n] + acc[ai][bj][m][n] * scale; }
    }
};
template <class Epi, class Sched, bool ALIGN_EPI = false, bool SP2 = false, bool ABLK = false, bool BBLK = false>
__device__ __forceinline__ void gemm_phase(PG8_LAS unsigned char* lds, const Gemm g, const Sched& S, const Epi& E, int tid_in) {
    int tid_ = tid_in; asm volatile("" : "+v"(tid_));
    const int tid = tid_, wid = __builtin_amdgcn_readfirstlane(tid >> 6), lane = tid & 63, wr = wid >> 2, wc = wid & 3, fr = lane & 15, fq = lane >> 4;
    const int K = g.K, nt = K / BK;
    unsigned voffA[2], voffB[2];
#pragma unroll
    for (int i = 0; i < 2; ++i) { int R, C; stage_rc(tid * 16 + i * 8192, R, C); const int Rb = Epi::PERM ? ((R & ~31) + perm32(R & 31)) : R;
        voffA[i] = (unsigned)(R * (ABLK ? BK : K) + C) * 2u; voffB[i] = (unsigned)(Rb * (BBLK ? BK : K) + C) * 2u; }
    const size_t kstepA = ABLK ? (size_t)BM * BK * 2 : (size_t)(BK * 2), kstepB = BBLK ? (size_t)BM * BK * 2 : (size_t)(BK * 2);
    const size_t hstepA = ABLK ? (size_t)HALF * BK * 2 : (size_t)HALF * K * 2, hstepB = BBLK ? (size_t)HALF * BK * 2 : (size_t)HALF * K * 2;
    const size_t tstep = (size_t)BM * K * 2;
    const unsigned ldsw = (unsigned)wid * 1024u;
    const int aoff = lds_byte(wr * 64 + fr, fq * 8), boff = lds_byte(wc * 32 + fr, fq * 8);
#define PG8_SA(b, h) (((b) * 2 + (h)) * HTB)
#define PG8_SB(b, h) ((4 + (b) * 2 + (h)) * HTB)
#define PG8_STAGE(bufoff, gbase, voff) do { _Pragma("unroll") for (int _i = 0; _i < 2; ++_i) \
        __builtin_amdgcn_global_load_lds((const unsigned*)((const char*)(gbase) + (voff)[_i]), (PG8_LAS unsigned*)(lds + (bufoff) + ldsw + _i * 8192), 16, 0, 0); } while (0)
#define PG8_LDA(dst, b, h) do { _Pragma("unroll") for (int m = 0; m < 4; ++m) _Pragma("unroll") for (int k = 0; k < 2; ++k) dst[m][k] = *(const PG8_LAS bf16x8*)(lds + PG8_SA(b, h) + aoff + m * 2048 + k * 1024); } while (0)
#define PG8_LDB(dst, b, h) do { _Pragma("unroll") for (int n = 0; n < 2; ++n) _Pragma("unroll") for (int k = 0; k < 2; ++k) dst[n][k] = *(const PG8_LAS bf16x8*)(lds + PG8_SB(b, h) + boff + n * 2048 + k * 1024); } while (0)
#define PG8_MMA(ai, bj, At, Bt) do { __builtin_amdgcn_s_setprio(1); _Pragma("unroll") for (int m = 0; m < 4; ++m) _Pragma("unroll") for (int n = 0; n < 2; ++n) _Pragma("unroll") for (int k = 0; k < 2; ++k) \
        acc[ai][bj][m][n] = __builtin_amdgcn_mfma_f32_16x16x32_bf16(Bt[n][k], At[m][k], acc[ai][bj][m][n], 0, 0, 0); __builtin_amdgcn_s_setprio(0); } while (0)
#define PG8_WAIT_V(n) asm volatile("s_waitcnt vmcnt(" #n ")" ::: "memory")
#define PG8_WAIT_L(n) asm volatile("s_waitcnt lgkmcnt(" #n ")" ::: "memory")
#define PG8_BAR __builtin_amdgcn_s_barrier()
#define PG8_SCHED __builtin_amdgcn_sched_barrier(0)
    Unit cur, nxt; int ui = 0;
    if (!S.next(0, cur)) return;
    f32x4 acc[2][2][4][2];
#pragma unroll
    for (int a = 0; a < 2; ++a)
#pragma unroll
        for (int b = 0; b < 2; ++b)
#pragma unroll
            for (int m = 0; m < 4; ++m)
#pragma unroll
                for (int n = 0; n < 2; ++n) acc[a][b][m][n] = (f32x4){0.f, 0.f, 0.f, 0.f};
    bf16x8 At[4][2], B0[2][2], B1[2][2];
    const char* cA = (const char*)g.A + (size_t)cur.pm * tstep; const char* cB = (const char*)g.Bt + (size_t)cur.pn * tstep;
    S.a_ready(cur);
    if constexpr (SP2) {
        PG8_STAGE(PG8_SB(0, 0), cB, voffB); PG8_STAGE(PG8_SB(0, 1), cB + hstepB, voffB); PG8_STAGE(PG8_SA(0, 0), cA, voffA); PG8_STAGE(PG8_SA(0, 1), cA + hstepA, voffA);
        if (wr == 1) PG8_BAR;
        PG8_WAIT_V(2); PG8_BAR;
        PG8_STAGE(PG8_SB(1, 0), cB + kstepB, voffB); PG8_STAGE(PG8_SA(1, 0), cA + kstepA, voffA); PG8_STAGE(PG8_SB(1, 1), cB + hstepB + kstepB, voffB);
        PG8_WAIT_V(6); PG8_BAR;
    } else {
        PG8_STAGE(PG8_SB(0, 0), cB, voffB); PG8_STAGE(PG8_SA(0, 0), cA, voffA); PG8_STAGE(PG8_SB(0, 1), cB + hstepB, voffB); PG8_STAGE(PG8_SA(0, 1), cA + hstepA, voffA);
        if (wr == 1) PG8_BAR;
        PG8_WAIT_V(4); PG8_BAR;
        PG8_STAGE(PG8_SB(1, 0), cB + kstepB, voffB); PG8_STAGE(PG8_SA(1, 0), cA + kstepA, voffA); PG8_STAGE(PG8_SB(1, 1), cB + hstepB + kstepB, voffB);
        PG8_WAIT_V(6); PG8_BAR;
    }
    for (;;) {
        const bool has_next = S.next(ui + 1, nxt);
        const char* nA = has_next ? (const char*)g.A + (size_t)nxt.pm * tstep : cA; const char* nB = has_next ? (const char*)g.Bt + (size_t)nxt.pn * tstep : cB;
        for (int t = 0; t < nt; t += 2) {
            const bool last = (t == nt - 2);
            const char* a1 = cA + (size_t)(t + 1) * kstepA;
            const char* a2 = last ? nA : cA + (size_t)(t + 2) * kstepA; const char* b2 = last ? nB : cB + (size_t)(t + 2) * kstepB;
            const char* a3 = a2 + kstepA; const char* b3 = b2 + kstepB;
            if (last && has_next) S.a_ready(nxt);
            if constexpr (SP2) {
            PG8_LDB(B0, 0, 0); PG8_LDB(B1, 0, 1); PG8_SCHED; PG8_LDA(At, 0, 0); PG8_STAGE(PG8_SA(1, 1), a1 + hstepA, voffA);
            PG8_WAIT_V(8); PG8_WAIT_L(0); PG8_BAR; PG8_MMA(0, 0, At, B0); PG8_MMA(0, 1, At, B1); PG8_BAR; PG8_SCHED;
            PG8_LDA(At, 0, 1); PG8_STAGE(PG8_SB(0, 0), b2, voffB); PG8_STAGE(PG8_SB(0, 1), b2 + hstepB, voffB); PG8_STAGE(PG8_SA(0, 0), a2, voffA);
            PG8_WAIT_V(8); PG8_WAIT_L(0); PG8_BAR; PG8_MMA(1, 0, At, B0); PG8_MMA(1, 1, At, B1); PG8_BAR; PG8_SCHED;
            PG8_LDB(B0, 1, 0); PG8_LDB(B1, 1, 1); PG8_SCHED; PG8_LDA(At, 1, 0); PG8_STAGE(PG8_SA(0, 1), a2 + hstepA, voffA);
            PG8_WAIT_V(8); PG8_WAIT_L(0); PG8_BAR; PG8_MMA(0, 0, At, B0); PG8_MMA(0, 1, At, B1); PG8_BAR; PG8_SCHED;
            PG8_LDA(At, 1, 1); PG8_STAGE(PG8_SB(1, 0), b3, voffB); PG8_STAGE(PG8_SB(1, 1), b3 + hstepB, voffB); PG8_STAGE(PG8_SA(1, 0), a3, voffA);
            PG8_WAIT_V(8); PG8_WAIT_L(0); PG8_BAR; PG8_MMA(1, 0, At, B0); PG8_MMA(1, 1, At, B1); PG8_BAR; PG8_SCHED;
            } else {
            PG8_LDB(B0, 0, 0); PG8_SCHED; PG8_LDA(At, 0, 0); PG8_STAGE(PG8_SA(1, 1), a1 + hstepA, voffA);
            PG8_WAIT_L(8); PG8_BAR; PG8_WAIT_L(0); PG8_MMA(0, 0, At, B0); PG8_BAR; PG8_SCHED;
            PG8_LDB(B1, 0, 1); PG8_STAGE(PG8_SB(0, 0), b2, voffB);
            PG8_BAR; PG8_WAIT_L(0); PG8_MMA(0, 1, At, B1); PG8_BAR;
            PG8_LDA(At, 0, 1); PG8_STAGE(PG8_SA(0, 0), a2, voffA);
            PG8_BAR; PG8_WAIT_L(0); PG8_MMA(1, 0, At, B0); PG8_BAR; PG8_SCHED;
            PG8_STAGE(PG8_SB(0, 1), b2 + hstepB, voffB);
            PG8_WAIT_V(6); PG8_BAR; PG8_MMA(1, 1, At, B1); PG8_BAR;
            PG8_LDB(B0, 1, 0); PG8_SCHED; PG8_LDA(At, 1, 0); PG8_STAGE(PG8_SA(0, 1), a2 + hstepA, voffA);
            PG8_WAIT_L(8); PG8_BAR; PG8_WAIT_L(0); PG8_MMA(0, 0, At, B0); PG8_BAR; PG8_SCHED;
            PG8_LDB(B1, 1, 1); PG8_STAGE(PG8_SB(1, 0), b3, voffB);
            PG8_BAR; PG8_WAIT_L(0); PG8_MMA(0, 1, At, B1); PG8_BAR;
            PG8_LDA(At, 1, 1); PG8_STAGE(PG8_SA(1, 0), a3, voffA);
            PG8_BAR; PG8_WAIT_L(0); PG8_MMA(1, 0, At, B0); PG8_BAR; PG8_SCHED;
            PG8_STAGE(PG8_SB(1, 1), b3 + hstepB, voffB);
            PG8_WAIT_V(6); PG8_BAR; PG8_MMA(1, 1, At, B1); PG8_BAR;
            }
        }
        if constexpr (ALIGN_EPI) { if (wr == 0) PG8_BAR; }
        if constexpr (!Epi::AFTER_DRAIN) { E(acc, cur, wr, wc, fr, fq); S.done(cur); }
        if (!has_next) break;
#pragma unroll
        for (int a = 0; a < 2; ++a)
#pragma unroll
            for (int b = 0; b < 2; ++b)
#pragma unroll
                for (int m = 0; m < 4; ++m)
#pragma unroll
                    for (int n = 0; n < 2; ++n) acc[a][b][m][n] = (f32x4){0.f, 0.f, 0.f, 0.f};
        cur = nxt; cA = nA; cB = nB; ++ui;
        if constexpr (ALIGN_EPI) { if (wr == 1) PG8_BAR; }
    }
    PG8_WAIT_V(0);
    if constexpr (!ALIGN_EPI) { if (wr == 0) PG8_BAR; }
    PG8_BAR;
    if constexpr (Epi::AFTER_DRAIN) { E.fused(acc, cur, wr, wc, fr, fq, lds, wid, lane); S.done(cur); }
#undef PG8_SA
#undef PG8_SB
#undef PG8_STAGE
#undef PG8_LDA
#undef PG8_LDB
#undef PG8_MMA
#undef PG8_WAIT_V
#undef PG8_WAIT_L
#undef PG8_BAR
#undef PG8_SCHED
}
}

#define GAS __attribute__((address_space(1)))
#define LAS __attribute__((address_space(3)))
typedef unsigned v4u __attribute__((ext_vector_type(4)));
typedef float f32x4 __attribute__((ext_vector_type(4)));
typedef GAS unsigned gu32;
#define RLX_AGENT __ATOMIC_RELAXED, __HIP_MEMORY_SCOPE_AGENT
#define LDS_WAIT() asm volatile("s_waitcnt lgkmcnt(0)" ::: "memory")
#define VM_WAIT() asm volatile("s_waitcnt vmcnt(0)" ::: "memory")
__device__ __forceinline__ unsigned pk2(float lo, float hi) { return f2bf(lo) | (f2bf(hi) << 16); }

#define XB_TMO      128
#define XB_XCNT(j)  (256  + 64 * (j))
#define XB_XSUB(j)  (1280 + 64 * (j))
#define XB_XGEN(j)  (2304 + 64 * (j))
#define XB_TOP      3328
#define XB_TOPGEN   3392
#define XCD_BAR_WORDS 3456
#define XB_SPIN_CAP (1u << 18)

__device__ __forceinline__ unsigned xb_ld(unsigned* p)              { return __hip_atomic_load(p, __ATOMIC_RELAXED, __HIP_MEMORY_SCOPE_AGENT); }
__device__ __forceinline__ unsigned xb_add(unsigned* p, unsigned v) { return __hip_atomic_fetch_add(p, v, __ATOMIC_RELAXED, __HIP_MEMORY_SCOPE_AGENT); }
__device__ __forceinline__ unsigned xb_xcc_id() { return (unsigned)__builtin_amdgcn_s_getreg((3 << 11) | 20) & 0xFu; }
#define XB_SPIN(cond, bar) do { unsigned _sp = 0; while (cond) { __builtin_amdgcn_s_sleep(1); \
    if ((++_sp & 255u) == 0u) { if (xb_ld(&(bar)[XB_TMO])) break; if (_sp > XB_SPIN_CAP) { atomicAdd(&(bar)[XB_TMO], 1u); break; } } } } while (0)

struct XcdBarrier {
    unsigned* bar; unsigned x;
    volatile LAS unsigned* st;
};

__device__ __forceinline__ XcdBarrier xcd_barrier_post(unsigned* bar, volatile LAS unsigned* st) {
    XcdBarrier b; b.bar = bar; b.x = xb_xcc_id(); b.st = st;
    if (threadIdx.x == 0) (void)xb_add(&bar[XB_XCNT(b.x)], 1u);
    return b;
}
__device__ __forceinline__ void xcd_barrier_complete(unsigned* bar, unsigned x, unsigned& nloc, unsigned& nx) {
    const unsigned G = gridDim.x * gridDim.y * gridDim.z;
    unsigned sum, cnt, mine, sp = 0u;
    for (;;) {
        sum = 0u; cnt = 0u; mine = 0u;
#pragma unroll
        for (unsigned j = 0; j < 16; ++j) { const unsigned c = xb_ld(&bar[XB_XCNT(j)]); sum += c; cnt += (c > 0u) ? 1u : 0u; mine = (j == x) ? c : mine; }
        if (sum == G) break;
        __builtin_amdgcn_s_sleep(1);
        if ((++sp & 255u) == 0u) { if (xb_ld(&bar[XB_TMO])) break; if (sp > XB_SPIN_CAP) { atomicAdd(&bar[XB_TMO], 1u); break; } }
    }
    nloc = mine > 0u ? mine : 1u; nx = cnt > 0u ? cnt : 1u;
}

__device__ __forceinline__ void xcd_barrier(const XcdBarrier& b) {
    asm volatile("s_waitcnt vmcnt(0)" ::: "memory");
    __syncthreads();
    if (threadIdx.x == 0) {
        unsigned* bar = b.bar;
        __builtin_amdgcn_s_waitcnt(0);
        unsigned nloc = b.st[0], nx = b.st[1];
        if (nloc == 0u) { xcd_barrier_complete(bar, b.x, nloc, nx); b.st[0] = nloc; b.st[1] = nx; }
        const unsigned old = xb_add(&bar[XB_XSUB(b.x)], 1u);
        const unsigned gen = old / nloc;
        if (old + 1u == (gen + 1u) * nloc) {
            __builtin_amdgcn_fence(__ATOMIC_RELEASE, "agent");
            asm volatile("s_waitcnt vmcnt(0)" ::: "memory");
            const unsigned og = xb_add(&bar[XB_TOP], 1u);
            const unsigned tg = og / nx;
            if (og + 1u == (tg + 1u) * nx) xb_add(&bar[XB_TOPGEN], 1u);
            else XB_SPIN(xb_ld(&bar[XB_TOPGEN]) == tg, bar);
            __builtin_amdgcn_fence(__ATOMIC_ACQUIRE, "agent");
            xb_add(&bar[XB_XGEN(b.x)], 1u);
            asm volatile("s_waitcnt vmcnt(0)" ::: "memory");
        } else {
            XB_SPIN(xb_ld(&bar[XB_XGEN(b.x)]) == gen, bar);
            __builtin_amdgcn_fence(__ATOMIC_ACQUIRE, "agent");
            asm volatile("s_waitcnt vmcnt(0)" ::: "memory");
        }
    }
    __syncthreads();
}

constexpr int NWAVES = 8, NTHREADS = NWAVES * 64;
constexpr size_t MiB = 1u << 20;
constexpr size_t WS_CTL = 0, CTL_ZERO_BYTES = 1 * MiB;
constexpr size_t UP_BYTES = (size_t)UP_N * D_MODEL * 2, DN_BYTES = (size_t)D_MODEL * D_FF * 2, EIN_BYTES = (size_t)IN_EVEN * D_MODEL * 2, SQ_BYTES = (size_t)D_MODEL * D_MODEL * 2, QKVW_BYTES = (size_t)QKV_N * D_MODEL * 2;
constexpr size_t WS_WUP = 4 * MiB, WS_WDN = WS_WUP + 8 * UP_BYTES, WS_WEIN = WS_WDN + 8 * DN_BYTES, WS_WEOUT = WS_WEIN + 2 * EIN_BYTES, WS_WQKV = WS_WEOUT + 2 * SQ_BYTES, WS_WWO = WS_WQKV + 2 * QKVW_BYTES;
constexpr size_t WS_H = WS_WWO + 2 * SQ_BYTES;
constexpr size_t WS_G = WS_H + (size_t)M * D_MODEL * 2;
constexpr size_t WS_Y = WS_G + (size_t)M * QKV_N * 2;
constexpr size_t WS_S = WS_Y + (size_t)M * D_MODEL * 2;
constexpr size_t SLAB = (size_t)M * 1024 * 4;
constexpr size_t WS_XB = WS_S, WS_A = WS_S + SLAB, WS_B = WS_S + 2 * SLAB, WS_HF = WS_S + 3 * SLAB, WS_HB = WS_S + 4 * SLAB;
constexpr size_t WS_U = WS_HF, WS_X0 = WS_HB;
constexpr size_t WS_OC = WS_S;
constexpr size_t WS_KF = WS_S + 5 * SLAB, WS_KB = WS_KF + (size_t)FILT_T * HW * 4;
constexpr size_t WS_UT = WS_HF, WS_X0T = WS_HB;
constexpr size_t WS_YT = WS_KF;
constexpr size_t F8_BYTES = (size_t)HW * 2 * DEC_SEQ * 2, F4_BYTES = (size_t)HW * 2 * SEQ * 2;
__host__ __device__ constexpr size_t ws_filt(int j) { return j == 0 ? WS_KB : WS_A; }
static_assert(N_EVEN == 2 && F8_BYTES + F4_BYTES <= (size_t)FILT_T * HW * 4 && F8_BYTES + F4_BYTES <= SLAB, "filter regions");
static_assert((size_t)HW * M * 2 <= SLAB && (size_t)HW * M * 2 <= (size_t)FILT_T * HW * 4 && (size_t)HW * 2 * (DEC_SEQ + SEQ) * 2 <= (size_t)FILT_T * HW * 4, "hyena staging fits the old f32 filter regions");
constexpr size_t WS_FH = WS_KB + (size_t)FILT_T * HW * 4;
constexpr size_t WS_LWT = WS_FH + (size_t)3 * N_EVEN * FILT_T * FO * 4;
constexpr size_t LWT_LAYER = (size_t)2 * 2 * LRU_BLOCKS * LB * LB;
constexpr int N_NORM = 3 * DEPTH + 1;
constexpr size_t WS_ROPE = WS_LWT + N_EVEN * LWT_LAYER * 2;
constexpr size_t WS_ROWSS = CTL_ZERO_BYTES;
constexpr size_t ROWSS_BYTES = (size_t)N_NORM * M * 8;
constexpr size_t WS_KMAX = WS_ROWSS + ROWSS_BYTES;
constexpr size_t KMAX_LAYER = 3 * 2 * ATT_HEADS, KMAX_BYTES = 1024;
static_assert(N_ODD * KMAX_LAYER * 4 <= KMAX_BYTES && BATCH == 2, "kmax region");
constexpr size_t ZERO_BYTES = WS_KMAX + KMAX_BYTES;
constexpr size_t WS_NSP = WS_WUP - 64 * 1024;
static_assert(ZERO_BYTES <= WS_NSP, "zeroed region ends before the weight copies");
constexpr size_t WS_END = WS_ROPE + (size_t)DEC_SEQ * (DH / 2) * 2 * 4;
constexpr size_t WS_AGG = WS_XB, WS_CARRY = WS_XB + 8 * MiB;
constexpr int CW_BAR = 4096;

constexpr int RING_OFF = 0, RING_BYTES = 131072;
constexpr int LDSCTL_OFF = RING_BYTES, MISC_OFF = LDSCTL_OFF + 320;
constexpr int LDS_BYTES = 147456;
static_assert(MISC_OFF + 128 <= LDS_BYTES, "LDS map");

constexpr int PH_PRO0 = 0, PH_PRO1 = 1, PH_PRO2 = 2, PH_PRO3 = 3, PH_LAYER0 = 4, PH_PER_LAYER = 15, PH_FINAL = PH_LAYER0 + DEPTH * PH_PER_LAYER, NPHASES = PH_FINAL + 1;
__host__ __device__ inline bool phase_exists(int k) { if (k < PH_LAYER0 || k == PH_FINAL) return k >= 0; if (k > PH_FINAL) return false; const int l = (k - PH_LAYER0) / PH_PER_LAYER, s = (k - PH_LAYER0) % PH_PER_LAYER; return !(s == 0 || s == 3 || s == 12) && !(s >= 8 && s <= 10) && !((l & 1) && (s == 5 || s == 7)); }

struct Args { const float* in[29]; float* out; unsigned char* ws; int ph_lo, ph_hi; };

struct Frame {
    LAS unsigned char* lds;
    int tid, lane, wave, G, gtid, gsize, gw, ngw, bid;
};
__device__ __forceinline__ Frame make_frame(LAS unsigned char* lds, int wave_sgpr) {
    unsigned z = 0u; asm volatile("" : "+v"(z));
    const int lane = (int)__builtin_amdgcn_mbcnt_hi(~0u, __builtin_amdgcn_mbcnt_lo(~0u, z));
    const int t = wave_sgpr * 64 + lane;
    Frame F; F.lds = lds; F.tid = t; F.lane = lane; F.wave = wave_sgpr;
    int b = blockIdx.x; asm volatile("" : "+s"(b));
    F.bid = b; F.G = gridDim.x; F.gtid = b * NTHREADS + t; F.gsize = F.G * NTHREADS; F.gw = b * NWAVES + F.wave; F.ngw = F.G * NWAVES;
    return F;
}
typedef const Args __attribute__((address_space(4))) CArgs;
__device__ __forceinline__ const CArgs* opaque_args() { const CArgs* a = (const CArgs*)__builtin_amdgcn_kernarg_segment_ptr(); asm volatile("" : "+s"(a)); return a; }
__device__ __forceinline__ float wave_sum(float v, int lane) {
#pragma unroll
    for (int o = 1; o < 64; o <<= 1) v += __builtin_bit_cast(float, __builtin_amdgcn_ds_bpermute((lane ^ o) << 2, __builtin_bit_cast(int, v)));
    return v;
}
__device__ __forceinline__ void transpose_tile(const float* W, int ldn, int K, int k0, int n0, bf16* WT, int drow0, LAS float* scr, int lane, const float* gain) {
    float tv[32];
    const float* wp = W + (size_t)(k0 + (lane >> 5)) * ldn + n0 + (lane & 31);
#pragma unroll
    for (int i = 0; i < 32; ++i) tv[i] = wp[(size_t)(2 * i) * ldn];
#pragma unroll
    for (int i = 0; i < 32; ++i) scr[(2 * i + (lane >> 5)) * 33 + (lane & 31)] = tv[i];
    LDS_WAIT(); asm volatile("" ::: "memory");
    const int c = lane & 7;
    float gk[8];
#pragma unroll
    for (int e = 0; e < 8; ++e) gk[e] = gain ? gain[k0 + 8 * c + e] : 1.0f;
#pragma unroll
    for (int j = 0; j < 4; ++j) { const int n = (lane >> 3) + 8 * j; const LAS float* s = scr + (8 * c) * 33 + n;
        v4u o; o.x = pk2(s[0 * 33] * gk[0], s[1 * 33] * gk[1]); o.y = pk2(s[2 * 33] * gk[2], s[3 * 33] * gk[3]); o.z = pk2(s[4 * 33] * gk[4], s[5 * 33] * gk[5]); o.w = pk2(s[6 * 33] * gk[6], s[7 * 33] * gk[7]);
        *(v4u*)(WT + (size_t)(drow0 + n) * K + k0 + 8 * c) = o; }
    LDS_WAIT(); asm volatile("" ::: "memory");
}
__device__ __forceinline__ void rms_row_to_bf16(const float* xrow, const float* g, bf16* orow, int lane) {
    const f32x4* xr = (const f32x4*)xrow + lane; const f32x4* gr = (const f32x4*)g + lane;
    f32x4 v[8]; float s = 0.f;
#pragma unroll
    for (int j = 0; j < 8; ++j) { v[j] = xr[64 * j]; s += (v[j].x * v[j].x + v[j].y * v[j].y) + (v[j].z * v[j].z + v[j].w * v[j].w); }
    const float rstd = 1.f / sqrtf(wave_sum(s, lane) * (1.f / D_MODEL) + NORM_EPS);
    unsigned long long* o8 = (unsigned long long*)orow + lane;
#pragma unroll
    for (int j = 0; j < 8; ++j) { const f32x4 gg = gr[64 * j];
        o8[64 * j] = (unsigned long long)pk2(v[j].x * rstd * gg.x, v[j].y * rstd * gg.y) | ((unsigned long long)pk2(v[j].z * rstd * gg.z, v[j].w * rstd * gg.w) << 32); }
}
__device__ __forceinline__ void rms_row_inplace_f32(float* xrow, const float* g, int lane) {
    f32x4* xr = (f32x4*)xrow + lane; const f32x4* gr = (const f32x4*)g + lane;
    f32x4 v[8]; float s = 0.f;
#pragma unroll
    for (int j = 0; j < 8; ++j) { v[j] = xr[64 * j]; s += (v[j].x * v[j].x + v[j].y * v[j].y) + (v[j].z * v[j].z + v[j].w * v[j].w); }
    const float rstd = 1.f / sqrtf(wave_sum(s, lane) * (1.f / D_MODEL) + NORM_EPS);
#pragma unroll
    for (int j = 0; j < 8; ++j) { const f32x4 gg = gr[64 * j]; xr[64 * j] = (f32x4){v[j].x * rstd * gg.x, v[j].y * rstd * gg.y, v[j].z * rstd * gg.z, v[j].w * rstd * gg.w}; }
}
static_assert(D_MODEL == 2048, "row helpers assume 2048-wide rows");

__device__ __forceinline__ void filter_chain_item(const CArgs& a, LAS float* hrow, int i) {
    const int q = i % FO, tt = (i / FO) % FILT_T, j = i / (FO * FILT_T);
    const float fq = a.in[14][j * FO + q];
    float h;
    {
      int L, pos; filt_pos(tt, L, pos);
      const float fp = (float)pos, tn = fp / (float)(L - 1 > 1 ? L - 1 : 1), wv = (6.283185307179586f / (float)L) * fp;
      const int e = q <= BANDS ? q - 1 : q - 1 - BANDS; const float band = 1e-4f + (float)e * ((float)(BANDS - 1) - 1e-4f) / (float)(BANDS - 1);
      float z = tn;
      if (q >= 1 && q <= BANDS) z = cosf(band * wv); else if (q > BANDS && q <= 2 * BANDS) z = -sinf(band * wv);
      LAS float* zrow = hrow + FO; zrow[q] = z;
      const float* w_in = a.in[11] + j * EMB * FO + q;
      float acc = a.in[12][j * 3 * FO + q];
#pragma unroll
      for (int k = 0; k < EMB; ++k) acc += zrow[k] * w_in[k * FO];
      h = sinf(fq * acc); }
#pragma unroll 1
    for (int layer = 0; layer < 2; ++layer) { const float* w = a.in[13] + (size_t)(j * 2 + layer) * FO * FO + q;
        hrow[q] = h;
        float acc = a.in[12][j * 3 * FO + (layer + 1) * FO + q];
#pragma unroll 8
        for (int r = 0; r < FO; ++r) acc += hrow[r] * w[r * FO];
        h = sinf(fq * acc); }
    ((float*)(a.ws + WS_FH) + (size_t)2 * N_EVEN * FILT_T * FO)[i] = h;
}
__device__ __forceinline__ void phase_prologue0(const Frame& F, const CArgs& a) {
    LAS float* scr = (LAS float*)(F.lds + RING_OFF + F.wave * 16384);
    unsigned char* ws = a.ws;
    constexpr int KT = D_MODEL / 64;
    constexpr int I_UP = KT * (UP_N / 32), I_DN = (D_FF / 64) * (D_MODEL / 32), I_EIN = KT * (IN_EVEN / 32), I_SQ = KT * (D_MODEL / 32), I_QKV = KT * (QKV_N / 32);
    constexpr int T_UP = 8 * I_UP, T_DN = 8 * I_DN, T_EIN = 2 * I_EIN, T_SQ = 2 * I_SQ, T_QKV = 2 * I_QKV;
    constexpr int NITEMS = T_UP + T_DN + T_EIN + T_SQ + T_QKV + T_SQ;
    LAS float* hrow = (LAS float*)(F.lds + RING_OFF + F.wave * 16384 + 12288);
    constexpr int FN = N_EVEN * FILT_T * FO; int fi = F.gtid, cnt = 0;
    for (int it = F.gw; it < NITEMS; it += F.ngw) {
        if (cnt++ % 6 == 0 && fi < FN) { filter_chain_item(a, hrow, fi); fi += F.gsize; }
        int r = it;
        if (r < T_UP) { const int mi = r / I_UP, q = r % I_UP, nblk = UP_N / 32, kb = q / nblk, nb = q % nblk, dn0 = 32 * nb;
            int which, col; up_row_src(dn0, which, col);
            const float* W = (which ? a.in[4] : a.in[3]) + (size_t)mi * D_MODEL * D_FF;
            transpose_tile(W, D_FF, D_MODEL, 64 * kb, col, (bf16*)(ws + WS_WUP + (size_t)mi * UP_BYTES), dn0, scr, F.lane, a.in[2] + (size_t)mi * D_MODEL); continue; }
        r -= T_UP;
        if (r < T_DN) { const int mi = r / I_DN, q = r % I_DN, nblk = D_MODEL / 32, kb = q / nblk, nb = q % nblk;
            transpose_tile(a.in[5] + (size_t)mi * D_FF * D_MODEL, D_MODEL, D_FF, 64 * kb, 32 * nb, (bf16*)(ws + WS_WDN + (size_t)mi * DN_BYTES), 32 * nb, scr, F.lane, nullptr); continue; }
        r -= T_DN;
        if (r < T_EIN) { const int mi = r / I_EIN, q = r % I_EIN, nblk = IN_EVEN / 32, kb = q / nblk, nb = q % nblk;
            transpose_tile(a.in[8] + (size_t)mi * D_MODEL * IN_EVEN, IN_EVEN, D_MODEL, 64 * kb, 32 * nb, (bf16*)(ws + WS_WEIN + (size_t)mi * EIN_BYTES), 32 * nb, scr, F.lane, a.in[6] + (size_t)(2 * mi) * D_MODEL); continue; }
        r -= T_EIN;
        if (r < T_SQ) { const int mi = r / I_SQ, q = r % I_SQ, nblk = D_MODEL / 32, kb = q / nblk, nb = q % nblk;
            transpose_tile(a.in[24] + (size_t)mi * D_MODEL * D_MODEL, D_MODEL, D_MODEL, 64 * kb, 32 * nb, (bf16*)(ws + WS_WEOUT + (size_t)mi * SQ_BYTES), 32 * nb, scr, F.lane, nullptr); continue; }
        r -= T_SQ;
        if (r < T_QKV) { const int mi = r / I_QKV, q = r % I_QKV, nblk = QKV_N / 32, kb = q / nblk, nb = q % nblk;
            transpose_tile(a.in[25] + (size_t)mi * D_MODEL * QKV_N, QKV_N, D_MODEL, 64 * kb, qkv_row_src(32 * nb), (bf16*)(ws + WS_WQKV + (size_t)mi * QKVW_BYTES), 32 * nb, scr, F.lane, a.in[6] + (size_t)(2 * mi + 1) * D_MODEL); continue; }
        r -= T_QKV;
        { const int mi = r / I_SQ, q = r % I_SQ, nblk = D_MODEL / 32, kb = q / nblk, nb = q % nblk;
            transpose_tile(a.in[28] + (size_t)mi * D_MODEL * D_MODEL, D_MODEL, D_MODEL, 64 * kb, 32 * nb, (bf16*)(ws + WS_WWO + (size_t)mi * SQ_BYTES), 32 * nb, scr, F.lane, nullptr); }
    }
    for (int i = F.gtid; i < N_EVEN * 2 * LW; i += F.gsize) ((float*)(ws + WS_NSP))[i] = -8.0f * softplusf_(-a.in[23][i]);
    { bf16* xb = (bf16*)(ws + WS_H); unsigned long long* rs0 = (unsigned long long*)(ws + WS_ROWSS);
      for (int m = F.gw; m < M; m += F.ngw) { const float* src = m < BATCH * SEQ ? a.in[0] + (size_t)m * D_MODEL : a.in[1] + (size_t)(m - BATCH * SEQ) * D_MODEL;
          const f32x4* xr = (const f32x4*)src + F.lane; f32x4* o = (f32x4*)(a.out + (size_t)m * D_MODEL) + F.lane; unsigned long long* o8 = (unsigned long long*)(xb + (size_t)m * D_MODEL) + F.lane; float s = 0.f;
#pragma unroll
          for (int j = 0; j < 8; ++j) { const f32x4 v = xr[64 * j]; o[64 * j] = v; s += (v.x * v.x + v.y * v.y) + (v.z * v.z + v.w * v.w); o8[64 * j] = (unsigned long long)pk2(v.x, v.y) | ((unsigned long long)pk2(v.z, v.w) << 32); }
          s = wave_sum(s, F.lane); if (F.lane == 0) rs0[m] = (unsigned long long)(s * 16777216.0f); } }
    { float* tab = (float*)(ws + WS_ROPE);
      for (int i = F.gtid; i < DEC_SEQ * (DH / 2); i += F.gsize) { const int d = i % (DH / 2), t = i / (DH / 2); const float inv = powf(10000.0f, -(float)(2 * d) / (float)DH), ang = (float)t * inv; tab[2 * i] = cosf(ang); tab[2 * i + 1] = sinf(ang); } }
    { bf16* lwt = (bf16*)(ws + WS_LWT);
      for (int i = F.gtid; i < (int)(N_EVEN * LWT_LAYER); i += F.gsize) { const int cc = i % LB, d = (i / LB) % LB, n = (i / (LB * LB)) % LRU_BLOCKS, ty = (i / (LB * LB * LRU_BLOCKS)) % 2, dir = (i / (LB * LB * LRU_BLOCKS * 2)) % 2, j = i / (LB * LB * LRU_BLOCKS * 4);
          lwt[i] = (bf16)f2bf((ty ? a.in[21] : a.in[19])[((((size_t)j * 2 + dir) * LRU_BLOCKS + n) * LB + cc) * LB + d]); } }
    for (; fi < FN; fi += F.gsize) filter_chain_item(a, hrow, fi);
}
__device__ __forceinline__ void phase_filter_hidden(const Frame& F, const CArgs& a, int layer) {
    const float* src = (const float*)(a.ws + WS_FH) + (size_t)layer * N_EVEN * FILT_T * FO; float* dst = (float*)(a.ws + WS_FH) + (size_t)(layer + 1) * N_EVEN * FILT_T * FO;
    for (int i = F.gtid; i < N_EVEN * FILT_T * FO; i += F.gsize) { const int q = i % FO, j = i / (FO * FILT_T);
        dst[i] = el_filt_hid(src + (size_t)(i / FO) * FO, a.in[13] + (size_t)(j * 2 + layer) * FO * FO, a.in[12] + j * 3 * FO + (layer + 1) * FO, a.in[14] + j * FO, q); }
}
__device__ __forceinline__ void phase_norm(const Frame& F, const float* x, const float* g, bf16* h) {
    for (int m = F.gw; m < M; m += F.ngw) rms_row_to_bf16(x + (size_t)m * D_MODEL, g, h + (size_t)m * D_MODEL, F.lane);
}
#ifdef CPU_EMU
#define LAS
#define DEVFN inline
typedef short bf16x8 __attribute__((ext_vector_type(8)));
typedef short s16x4 __attribute__((ext_vector_type(4)));
typedef float f32x16 __attribute__((ext_vector_type(16)));
typedef unsigned u32x4 __attribute__((ext_vector_type(4)));
#define MFMA32(a, b, c) emu::mfma32(a, b, c)
#define MFMA16F32(a, b, c) emu::mfma16f32(a, b, c)
#define LDS_TR16(p) emu::tr16(p)
#define BPERM(i, v) emu::bpermute(i, v)
#define SYNC() emu::bsync()
#define ANY(p) emu::any(p)
#define CVTPK(lo, hi) emu::cvt_pk_bf16(lo, hi)
#define EXP2(x) exp2f(x)
#define RCP(x) (1.0f / (x))
#define UNIFORM(x) (x)
#define OPAQUE_V(x) ((void)0)
#define GLDS16(gp, lp) memcpy((unsigned char*)(lp) + 16 * emu::lane, (const void*)(gp), 16)
#define WAITV(n) ((void)0)
#define BAR_RAW() emu::bsync()
#else
#define DEVFN __device__ __forceinline__
typedef short bf16x8 __attribute__((ext_vector_type(8)));
typedef short s16x4 __attribute__((ext_vector_type(4)));
typedef float f32x16 __attribute__((ext_vector_type(16)));
typedef unsigned u32x4 __attribute__((ext_vector_type(4)));
#define MFMA32(a, b, c) __builtin_amdgcn_mfma_f32_32x32x16_bf16(a, b, c, 0, 0, 0)
#define MFMA16F32(a, b, c) __builtin_amdgcn_mfma_f32_16x16x4f32(a, b, c, 0, 0, 0)
#define LDS_TR16(p) __builtin_amdgcn_ds_read_tr16_b64_v4i16((LAS s16x4*)(p))
#define BPERM(i, v) __builtin_amdgcn_ds_bpermute(i, v)
#define SYNC() __syncthreads()
#define ANY(p) (__builtin_amdgcn_ballot_w64(p) != 0ull)
typedef __bf16 bf16x2_t __attribute__((ext_vector_type(2)));
typedef float f32x2_t __attribute__((ext_vector_type(2)));
DEVFN unsigned cvt_pk_visible(float lo, float hi) { const f32x2_t v = {lo, hi}; return __builtin_bit_cast(unsigned, __builtin_convertvector(v, bf16x2_t)); }
#define CVTPK(lo, hi) cvt_pk_visible(lo, hi)
#define EXP2(x) __builtin_amdgcn_exp2f(x)
#define RCP(x) __builtin_amdgcn_rcpf(x)
#define UNIFORM(x) __builtin_amdgcn_readfirstlane(x)
#define OPAQUE_V(x) asm volatile("" : "+v"(x))
DEVFN void glds16_asm(const void* gsrc, unsigned lds_dst) { unsigned keep;
    asm volatile("s_mov_b32 %0, m0\n\ts_mov_b32 m0, %2\n\ts_nop 0\n\tglobal_load_lds_dwordx4 %1, off\n\ts_mov_b32 m0, %0" : "=&s"(keep) : "v"(gsrc), "s"(lds_dst) : "memory"); }
#define GLDS16(gp, lp) glds16_asm((const void*)(gp), (unsigned)__builtin_amdgcn_readfirstlane((int)(unsigned)(size_t)(lp)))
#define WAITV(n) asm volatile("s_waitcnt vmcnt(" #n ")" ::: "memory")
#define BAR_RAW() do { asm volatile("s_waitcnt lgkmcnt(0)" ::: "memory"); __builtin_amdgcn_s_barrier(); asm volatile("" ::: "memory"); } while (0)
#endif
DEVFN float bperm_f(int byte_idx, float v) { return __builtin_bit_cast(float, BPERM(byte_idx, __builtin_bit_cast(int, v))); }
DEVFN unsigned off_b(unsigned row, unsigned ch) { return 256u * row + 16u * (ch ^ (((row & 3) << 2) | ((row >> 2) & 3))); }

constexpr int AT_QROWS = 128, AT_KT = 64;
#ifndef AT_SHIFT_THR
#define AT_SHIFT_THR 60.f
#endif
DEVFN void attn_phase(LAS unsigned char* lds, const bf16* qkv, bf16* Y, const float* subln, const unsigned* kmax2  , float lam, float omli, int tid, int bid, int G) {
    const int lane = tid & 63, wave = UNIFORM(tid >> 6), comp = wave & 1, grp = wave >> 2, qg = wave >> 1, h5 = lane >> 5, l31 = lane & 31;
    constexpr int NQB = M / AT_QROWS, NU = NQB * ATT_HEADS;
    const unsigned blk = (lane >> 4) & 1, qq = (lane & 15) >> 2, pp = lane & 3;
    unsigned vb8[2][4];
#pragma unroll
    for (int t8 = 0; t8 < 2; ++t8)
#pragma unroll
        for (int eb = 0; eb < 4; ++eb) vb8[t8][eb] = off_b(4 * h5 + qq + 8 * t8, 4 * eb + 2 * blk + (pp >> 1)) + 8 * (pp & 1);
    for (int un = bid; un < NU; un += G) {
        const int head = un % ATT_HEADS, qblk = un / ATT_HEADS, m0 = qblk * AT_QROWS;
        const int row0 = m0 < BATCH * SEQ ? (m0 / SEQ) * SEQ : BATCH * SEQ, len = m0 < BATCH * SEQ ? SEQ : DEC_SEQ, ntiles = len / AT_KT;
        const int myrow = m0 + 32 * qg + l31;
        bf16x8 qf[4];
#pragma unroll
        for (int ks = 0; ks < 4; ++ks) qf[ks] = *(const bf16x8*)(qkv + (size_t)myrow * QKV_N + (head * 2 + comp) * DH + 16 * ks + 8 * h5);
        f32x16 O[4];
#pragma unroll
        for (int eb = 0; eb < 4; ++eb)
#pragma unroll
            for (int r = 0; r < 16; ++r) O[eb][r] = 0.f;
        unsigned goff[2];
#pragma unroll
        for (int jq = 0; jq < 2; ++jq) { const int q = 2 * wave + jq, prow = 4 * q + (lane >> 4), pch = (lane & 15) ^ ((((lane >> 4) & 3) << 2) | (q & 3)); goff[jq] = (unsigned)((prow * QKV_N + pch * 8) * 2); }
        const unsigned char* gkb = (const unsigned char*)(qkv + (size_t)row0 * QKV_N + D_MODEL + head * 2 * DH);
        const unsigned char* gvb = (const unsigned char*)(qkv + (size_t)row0 * QKV_N + 2 * D_MODEL + head * DV);
#define AT_DMA(tile) do { const size_t tb_ = (size_t)(tile) * AT_KT * QKV_N * 2; LAS unsigned char* sl_ = lds + (unsigned)((tile) & 3) * 32768u + (unsigned)wave * 2048u; \
            GLDS16(gkb + tb_ + goff[0], sl_); GLDS16(gkb + tb_ + goff[1], sl_ + 1024); GLDS16(gvb + tb_ + goff[0], sl_ + 16384); GLDS16(gvb + tb_ + goff[1], sl_ + 16384 + 1024); } while (0)
        AT_DMA(0);
        if (ntiles > 1) AT_DMA(1);
        float lrun = 0.f; f32x16 Cneg;
        { float qs2 = 0.f;
#pragma unroll
          for (int ks = 0; ks < 4; ++ks)
#pragma unroll
              for (int e = 0; e < 8; ++e) { const float qv = bf2f((unsigned)(unsigned short)qf[ks][e]); qs2 += qv * qv; }
          qs2 += bperm_f((lane ^ 32) << 2, qs2);
          const int sq = m0 < BATCH * SEQ ? m0 / SEQ : BATCH; const float km2 = __builtin_bit_cast(float, kmax2[sq * 2 * ATT_HEADS + head * 2 + comp]);
          const float mneg = -sqrtf(qs2 * km2) * 1.01f;
#pragma unroll
          for (int r = 0; r < 16; ++r) Cneg[r] = mneg; }
        if (ntiles > 1) { WAITV(4); } else { WAITV(0); }
        BAR_RAW();
        unsigned pk[2][8];
#define AT_LOADV(dst, g) do { _Pragma("unroll") for (int eb = 0; eb < 4; ++eb) { dst[2 * eb] = LDS_TR16(vp_[0][eb] + 4096 * (g)); dst[2 * eb + 1] = LDS_TR16(vp_[1][eb] + 4096 * (g)); } } while (0)
#define AT_MMA4(src, g) do { const u32x4 pw = (u32x4){pk[(g) >> 1][4 * ((g) & 1)], pk[(g) >> 1][4 * ((g) & 1) + 1], pk[(g) >> 1][4 * ((g) & 1) + 2], pk[(g) >> 1][4 * ((g) & 1) + 3]}; const bf16x8 pf = __builtin_bit_cast(bf16x8, pw); \
                _Pragma("unroll") for (int eb = 0; eb < 4; ++eb) { const bf16x8 vf = __builtin_shufflevector(src[2 * eb], src[2 * eb + 1], 0, 1, 2, 3, 4, 5, 6, 7); \
                    O[eb] = MFMA32(vf, pf, O[eb]); } } while (0)
#define AT_PV(slot) do { const LAS unsigned char* Vb_ = lds + (unsigned)(slot) * 32768u + 16384u; s16x4 va[8], vb[8]; const LAS unsigned char* vp_[2][4]; \
            _Pragma("unroll") for (int t8 = 0; t8 < 2; ++t8) _Pragma("unroll") for (int eb = 0; eb < 4; ++eb) vp_[t8][eb] = Vb_ + vb8[t8][eb];     \
            AT_LOADV(va, 0); AT_LOADV(vb, 1); AT_MMA4(va, 0); AT_LOADV(va, 2); AT_MMA4(vb, 1); AT_LOADV(vb, 3); AT_MMA4(va, 2); AT_MMA4(vb, 3); } while (0)
#define AT_TILELOOP(C0_) \
        for (int t = 0; t < ntiles; ++t) { \
            const bool more = t + 2 < ntiles; \
            if (more) AT_DMA(t + 2); \
            if (grp == 1 && t > 0) AT_PV((t - 1) & 3); \
            const LAS unsigned char* Kb = lds + (unsigned)(t & 3) * 32768u; \
            f32x16 S[2]; bf16x8 kfr[2][4]; \
        _Pragma("unroll") \
            for (int kb = 0; kb < 2; ++kb) \
        _Pragma("unroll") \
                for (int ks = 0; ks < 4; ++ks) kfr[kb][ks] = *(const LAS bf16x8*)(Kb + off_b(32 * kb + l31, 8 * comp + 2 * ks + h5)); \
        _Pragma("unroll") \
            for (int kb = 0; kb < 2; ++kb) S[kb] = MFMA32(kfr[kb][0], qf[0], C0_); \
        _Pragma("unroll") \
            for (int ks = 1; ks < 4; ++ks) \
        _Pragma("unroll") \
                for (int kb = 0; kb < 2; ++kb) S[kb] = MFMA32(kfr[kb][ks], qf[ks], S[kb]); \
            float psum = 0.f; \
        _Pragma("unroll") \
            for (int kb = 0; kb < 2; ++kb) \
        _Pragma("unroll") \
                for (int i = 0; i < 8; ++i) { const float p0 = EXP2(S[kb][2 * i]), p1 = EXP2(S[kb][2 * i + 1]); psum += p0 + p1; pk[kb][i] = CVTPK(p0, p1); } \
            lrun += psum; \
            if (grp == 0) AT_PV(t & 3); \
            if (more) WAITV(4); else WAITV(0); \
            BAR_RAW(); \
        }
        { const f32x16 Z16 = {0.f, 0.f, 0.f, 0.f, 0.f, 0.f, 0.f, 0.f, 0.f, 0.f, 0.f, 0.f, 0.f, 0.f, 0.f, 0.f};
          if (ANY(Cneg[0] < -(AT_SHIFT_THR))) { AT_TILELOOP(Cneg) } else { AT_TILELOOP(Z16) } }
#undef AT_TILELOOP
        if (grp == 1) AT_PV((ntiles - 1) & 3);
        SYNC();
#undef AT_LOADV
#undef AT_MMA4
#undef AT_PV
#undef AT_DMA
        const float ltot = lrun + bperm_f((lane ^ 32) << 2, lrun), inv = RCP(ltot);
        LAS float* xch = (LAS float*)(lds + qg * 16384);
        if (comp == 1) {
#pragma unroll
            for (int eb = 0; eb < 4; ++eb)
#pragma unroll
                for (int r = 0; r < 16; ++r) xch[(eb * 16 + r) * 64 + lane] = O[eb][r] * inv;
        }
        SYNC();
        if (comp == 0) {
            float ss = 0.f;
#pragma unroll
            for (int eb = 0; eb < 4; ++eb)
#pragma unroll
                for (int r = 0; r < 16; ++r) { const float d = O[eb][r] * inv - lam * xch[(eb * 16 + r) * 64 + lane]; O[eb][r] = d; ss += d * d; }
            ss += bperm_f((lane ^ 32) << 2, ss);
            const float rs = omli / sqrtf(ss * (1.0f / DV) + NORM_EPS);
            bf16* yrow = Y + (size_t)myrow * D_MODEL + head * DV;
#pragma unroll
            for (int eb = 0; eb < 4; ++eb)
#pragma unroll
                for (int g4 = 0; g4 < 4; ++g4) { const int e0 = 32 * eb + 8 * g4 + 4 * h5;
                    const float y0 = O[eb][4 * g4 + 0] * rs * subln[e0 + 0], y1 = O[eb][4 * g4 + 1] * rs * subln[e0 + 1], y2 = O[eb][4 * g4 + 2] * rs * subln[e0 + 2], y3 = O[eb][4 * g4 + 3] * rs * subln[e0 + 3];
                    *(unsigned long long*)(yrow + e0) = (unsigned long long)CVTPK(y0, y1) | ((unsigned long long)CVTPK(y2, y3) << 32); }
        }
        SYNC();
    }
}
namespace pg8 {
typedef unsigned long long rowss_t;
constexpr float ROWSS_SCALE = 16777216.0f;
#ifdef CPU_EMU
#define ATOMIC_ADD_U64(p, v) __atomic_fetch_add(p, v, __ATOMIC_RELAXED)
#define ATOMIC_MAX_U32(p, v) do { unsigned o_ = __atomic_load_n(p, __ATOMIC_RELAXED); while (o_ < (v) && !__atomic_compare_exchange_n(p, &o_, (v), true, __ATOMIC_RELAXED, __ATOMIC_RELAXED)) {} } while (0)
#define RSQ(x) (1.0f / sqrtf(x))
#define ROWGROUP_FENCE() ((void)0)
#define EPI_SCHED_FENCE() ((void)0)
#else
#define ATOMIC_ADD_U64(p, v) atomicAdd(p, v)
#define ATOMIC_MAX_U32(p, v) atomicMax(p, v)
#define RSQ(x) __builtin_amdgcn_rsqf(x)
#define ROWGROUP_FENCE() asm volatile("" ::: "memory")
#define EPI_SCHED_FENCE() __builtin_amdgcn_sched_barrier(0)
#endif
struct EpiResidNorm {
    static constexpr bool PERM = true, AFTER_DRAIN = false;
    float* X; bf16_t* XB; rowss_t* rowss; int ldc; float scale;
    DEVFN void operator()(const f32x4 (&acc)[2][2][4][2], const Unit& u, int wr, int wc, int fr, int fq) const {
        const int row0 = u.pm * BM + wr * 64 + fr, col0 = u.pn * BM + wc * 32 + 8 * fq, lane = fr + 16 * fq;
#pragma unroll
        for (int ai = 0; ai < 2; ++ai)
#pragma unroll
            for (int m = 0; m < 4; ++m) { const int row = row0 + ai * HALF + m * 16; float* rowp = X + (size_t)row * ldc + col0; bf16_t* rowb = XB + (size_t)row * ldc + col0;
                f32x4 v[2][2];
#pragma unroll
                for (int bj = 0; bj < 2; ++bj)
#pragma unroll
                    for (int n = 0; n < 2; ++n) v[bj][n] = *(const f32x4*)(rowp + bj * HALF + n * 4);
                float ss = 0.f;
#pragma unroll
                for (int bj = 0; bj < 2; ++bj) { f32x4 o[2];
#pragma unroll
                    for (int n = 0; n < 2; ++n) { o[n] = v[bj][n] + acc[ai][bj][m][n] * scale; *(f32x4*)(rowp + bj * HALF + n * 4) = o[n];
                        ss += (o[n][0] * o[n][0] + o[n][1] * o[n][1]) + (o[n][2] * o[n][2] + o[n][3] * o[n][3]); }
                    *(u32x4*)(rowb + bj * HALF) = (u32x4){CVTPK(o[0][0], o[0][1]), CVTPK(o[0][2], o[0][3]), CVTPK(o[1][0], o[1][1]), CVTPK(o[1][2], o[1][3])}; }
                ss += bperm_f((lane ^ 16) << 2, ss); ss += bperm_f((lane ^ 32) << 2, ss);
                if (fq == 0) ATOMIC_ADD_U64(rowss + row, (rowss_t)(ss * ROWSS_SCALE)); ROWGROUP_FENCE(); }
    }
};
DEVFN size_t blk_off(int row, int col, int K) { return ((size_t)((row >> 8) * (K >> 6) + (col >> 6)) * 256 + (row & 255)) * 64 + (col & 63); }
DEVFN float rstd_of(const rowss_t* rowss, int row) { return RSQ((float)rowss[row] * (1.0f / (ROWSS_SCALE * D_MODEL)) + NORM_EPS); }
DEVFN void rstd8(const rowss_t* rowss, int rowbase, int fr, int fq, float (&rs)[2][4]) {
    const int lane = fr + 16 * fq; const float r0 = rstd_of(rowss, rowbase + lane), r1 = rstd_of(rowss, rowbase + HALF + lane);
#pragma unroll
    for (int m = 0; m < 4; ++m) { rs[0][m] = bperm_f((m * 16 + fr) << 2, r0); rs[1][m] = bperm_f((m * 16 + fr) << 2, r1); }
}
struct EpiSwiGLUNorm {
    static constexpr bool PERM = true, AFTER_DRAIN = false;
    bf16_t* O; int ldc; const rowss_t* rowss;
    DEVFN void operator()(const f32x4 (&acc)[2][2][4][2], const Unit& u, int wr, int wc, int fr, int fq) const {
        const int row0 = u.pm * BM + wr * 64 + fr, col0 = u.pn * HALF + wc * 32 + 8 * fq;
        float rsv[2][4]; rstd8(rowss, u.pm * BM + wr * 64, fr, fq, rsv);
#pragma unroll
        for (int ai = 0; ai < 2; ++ai)
#pragma unroll
            for (int m = 0; m < 4; ++m) { const int row = row0 + ai * HALF + m * 16; const float rs = rsv[ai][m]; float g[8];
#pragma unroll
                for (int n = 0; n < 2; ++n)
#pragma unroll
                    for (int j = 0; j < 4; ++j) { const float h1 = acc[ai][0][m][n][j] * rs, h3 = acc[ai][1][m][n][j] * rs; g[4 * n + j] = h1 * RCP(1.0f + EXP2(-1.4426950408889634f * h1)) * h3; }
                *(u32x4*)(O + blk_off(row, col0, ldc)) = (u32x4){CVTPK(g[0], g[1]), CVTPK(g[2], g[3]), CVTPK(g[4], g[5]), CVTPK(g[6], g[7])}; }
    }
};
struct EpiBf16Norm {
    static constexpr bool PERM = true, AFTER_DRAIN = false;
    bf16_t* O; int ldc; const rowss_t* rowss;
    DEVFN void operator()(const f32x4 (&acc)[2][2][4][2], const Unit& u, int wr, int wc, int fr, int fq) const {
        const int row0 = u.pm * BM + wr * 64 + fr, col0 = u.pn * BM + wc * 32 + 8 * fq;
        float rsv[2][4]; rstd8(rowss, u.pm * BM + wr * 64, fr, fq, rsv);
#pragma unroll
        for (int ai = 0; ai < 2; ++ai)
#pragma unroll
            for (int m = 0; m < 4; ++m) { const int row = row0 + ai * HALF + m * 16; const float rs = rsv[ai][m];
#pragma unroll
                for (int bj = 0; bj < 2; ++bj) { const f32x4 v0 = acc[ai][bj][m][0] * rs, v1 = acc[ai][bj][m][1] * rs;
                    *(u32x4*)(O + (size_t)row * ldc + col0 + bj * HALF) = (u32x4){CVTPK(v0[0], v0[1]), CVTPK(v0[2], v0[3]), CVTPK(v1[0], v1[1]), CVTPK(v1[2], v1[3])}; } }
    }
};
struct EpiQKVRope {
    static constexpr bool PERM = true, AFTER_DRAIN = false;
    bf16_t* O; int ldc; const rowss_t* rowss; const float* ropetab  ; float qscale; unsigned* kmax2  ;
    DEVFN void operator()(const f32x4 (&acc)[2][2][4][2], const Unit& u, int wr, int wc, int fr, int fq) const {
        const int row0 = u.pm * BM + wr * 64 + fr;
        float rsv[2][4]; rstd8(rowss, u.pm * BM + wr * 64, fr, fq, rsv);
        if (u.pn >= 2 * D_MODEL / 256) {
            const int col0 = u.pn * BM + wc * 32 + 8 * fq;
#pragma unroll
            for (int ai = 0; ai < 2; ++ai)
#pragma unroll
                for (int m = 0; m < 4; ++m) { const int row = row0 + ai * HALF + m * 16; const float rs = rsv[ai][m];
#pragma unroll
                    for (int bj = 0; bj < 2; ++bj) { const f32x4 v0 = acc[ai][bj][m][0] * rs, v1 = acc[ai][bj][m][1] * rs;
                        *(u32x4*)(O + (size_t)row * ldc + col0 + bj * HALF) = (u32x4){CVTPK(v0[0], v0[1]), CVTPK(v0[2], v0[3]), CVTPK(v1[0], v1[1]), CVTPK(v1[2], v1[3])}; } }
            return; }
        const float qs = u.pn < D_MODEL / 256 ? qscale : 1.0f; const int colb = (u.pn * 4 + wc) * DH + 8 * fq;
        const bool is_k = u.pn >= D_MODEL / 256; float kmx = 0.f; const int lane = fr + 16 * fq;
#pragma unroll
        for (int ai = 0; ai < 2; ++ai)
#pragma unroll
            for (int m = 0; m < 4; ++m) { const int row = row0 + ai * HALF + m * 16; const float rs = rsv[ai][m] * qs;
                const int t = row < BATCH * SEQ ? row % SEQ : row - BATCH * SEQ; const f32x4* tb = (const f32x4*)(ropetab + ((size_t)t * (DH / 2) + 8 * fq) * 2);
                float lo[8], hi[8];
#pragma unroll
                for (int q = 0; q < 4; ++q) { const f32x4 cs = tb[q];
#pragma unroll
                    for (int e = 0; e < 2; ++e) { const int d = 2 * q + e; const float c = cs[2 * e], s = cs[2 * e + 1], l = acc[ai][0][m][d >> 2][d & 3] * rs, h = acc[ai][1][m][d >> 2][d & 3] * rs;
                        lo[d] = l * c - h * s; hi[d] = h * c + l * s; } }
                bf16_t* op = O + (size_t)row * ldc + colb;
                *(u32x4*)op = (u32x4){CVTPK(lo[0], lo[1]), CVTPK(lo[2], lo[3]), CVTPK(lo[4], lo[5]), CVTPK(lo[6], lo[7])};
                *(u32x4*)(op + DH / 2) = (u32x4){CVTPK(hi[0], hi[1]), CVTPK(hi[2], hi[3]), CVTPK(hi[4], hi[5]), CVTPK(hi[6], hi[7])};
                if (is_k) { float ss = 0.f;
#pragma unroll
                    for (int d = 0; d < 8; ++d) ss += lo[d] * lo[d] + hi[d] * hi[d];
                    ss += bperm_f((lane ^ 16) << 2, ss); ss += bperm_f((lane ^ 32) << 2, ss); kmx = fmaxf(kmx, ss); }
                ROWGROUP_FENCE(); }
        if (is_k) {
#pragma unroll
            for (int o = 1; o < 16; o <<= 1) kmx = fmaxf(kmx, bperm_f((lane ^ o) << 2, kmx));
            const int r0 = u.pm * BM, sq = r0 < BATCH * SEQ ? r0 / SEQ : BATCH;
            if (lane == 0) ATOMIC_MAX_U32(kmax2 + sq * 2 * ATT_HEADS + (u.pn * 4 + wc - 2 * ATT_HEADS), __builtin_bit_cast(unsigned, kmx)); }
    }
};
}
constexpr int HY_PAD = 32;
template <int L> struct HyGeom { static constexpr int NI = L / 32, NCB = L / 1024, PLANE = (L / 32 + 2 * HY_PAD) * 16, UBYTES = 4 * PLANE; };
static_assert(SEQ % 1024 == 0 && DEC_SEQ % 1024 == 0 && DEC_SEQ / 1024 <= 8 && 2 * (SEQ / 1024) <= 8, "hyena conv geometry");
constexpr int HY_KOFF = 64  , HY_KCOPY = 2 * DEC_SEQ * 2 + 64, HY_UOFF = HY_KOFF + 2 * HY_KCOPY;
constexpr int HY_UOFF2 = HY_UOFF + HyGeom<DEC_SEQ>::UBYTES;
static_assert(HY_UOFF2 + BATCH * HyGeom<SEQ>::UBYTES <= 131072, "hyena LDS map");

template <int L> DEVFN void hy_stage_u(LAS unsigned char* ubase, const bf16* ut_seq, int tid) {
    typedef HyGeom<L> Gm;
    for (int p = tid; p < L / 8; p += 512) { const int jb = p >> 1, half = p & 1; const u32x4 v = *(const u32x4*)(ut_seq + 8 * p);
        *(LAS u32x4*)(ubase + ((jb & 1) * 2 + half) * Gm::PLANE + 16 * ((jb >> 1) + HY_PAD)) = v; }
}
template <int L> DEVFN void hy_zero_pads(LAS unsigned char* ubase, int tid) {
    typedef HyGeom<L> Gm;
    unsigned zz = 0u; OPAQUE_V(zz);
    for (int z = tid; z < 4 * 2 * HY_PAD; z += 512) { const int pl = z / (2 * HY_PAD), k = z % (2 * HY_PAD);
        *(LAS u32x4*)(ubase + pl * Gm::PLANE + 16 * (k < HY_PAD ? k : (L / 32) + k)) = (u32x4){zz, zz, zz, zz}; }
}
template <int NP> struct HyFilt { u32x4 pc[NP]; unsigned nx[NP]; };
template <int L, int NP> DEVFN void hy_filter_load(HyFilt<NP>& F, const bf16* fsrc, int tid) {
    static_assert(NP * 512 * 8 >= 2 * L, "pieces per thread");
#pragma unroll
    for (int k = 0; k < NP; ++k) { const int p = tid + 512 * k; if (p < 2 * L / 8) { F.pc[k] = *(const u32x4*)(fsrc + 8 * p); F.nx[k] = p + 1 < 2 * L / 8 ? *(const unsigned*)(fsrc + 8 * p + 8) : 0u; } }
}
template <int L, int NP> DEVFN void hy_filter_write(LAS unsigned char* lds, const HyFilt<NP>& F, int tid) {
#pragma unroll
    for (int k = 0; k < NP; ++k) { const int p = tid + 512 * k; if (p >= 2 * L / 8) continue; const u32x4 v = F.pc[k];
        *(LAS u32x4*)(lds + HY_KOFF + 16 * p) = v;
        *(LAS u32x4*)(lds + HY_KOFF + HY_KCOPY + 16 * p) = (u32x4){(v[0] >> 16) | (v[1] << 16), (v[1] >> 16) | (v[2] << 16), (v[2] >> 16) | (v[3] << 16), (v[3] >> 16) | (F.nx[k] << 16)}; }
}
template <int L> DEVFN void hy_wave_conv(const LAS unsigned char* kflds, const LAS unsigned char* ubase, int cb, int lane, f32x16& acc) {
    typedef HyGeom<L> Gm;
    static_assert((L / 16) % 4 == 0, "first step odd, step count 2 mod 4");
    const int n = lane & 31, h5 = lane >> 5, par = (n + 1) & 1;
#pragma unroll
    for (int r = 0; r < 16; ++r) acc[r] = 0.f;
    const int mlo = 64 * cb - (L / 16 - 1), mhi = 64 * cb + 62, nst = mhi - mlo + 1, ngr = nst >> 2;
    const int mu0 = (mlo + 1) >> 1;
    const volatile LAS unsigned* pA = (const volatile LAS unsigned*)(kflds + par * HY_KCOPY) + ((L - 1 - 16 * mlo - n + 8 * h5 - par) >> 1) - 24;
    const LAS unsigned char* pO = ubase + (2 + h5) * Gm::PLANE + 16 * (32 * cb + n - mu0 + HY_PAD) - 16;
    const LAS unsigned char* pE = ubase + (0 + h5) * Gm::PLANE + 16 * (32 * cb + n - mu0 + HY_PAD) - 16;
#define HY_LDA(A, k) do { const unsigned w0 = pA[24 - 8 * (k)], w1 = pA[25 - 8 * (k)], w2 = pA[26 - 8 * (k)], w3 = pA[27 - 8 * (k)]; A = __builtin_bit_cast(bf16x8, (u32x4){w0, w1, w2, w3}); } while (0)
#define HY_LDG(A, B) do { HY_LDA(A[0], 0); B[0] = *(const LAS bf16x8*)(pO + 16); HY_LDA(A[1], 1); B[1] = *(const LAS bf16x8*)(pE + 16); \
        HY_LDA(A[2], 2); B[2] = *(const LAS bf16x8*)pO; HY_LDA(A[3], 3); B[3] = *(const LAS bf16x8*)pE; } while (0)
    bf16x8 fa[4], fb[4], na[4], nb[4];
    HY_LDG(fa, fb);
    for (int gi = 0; gi < ngr; ++gi) {
        pA -= 32; pO -= 32; pE -= 32;
        HY_LDG(na, nb);
#pragma unroll
        for (int k = 0; k < 4; ++k) acc = MFMA32(fa[k], fb[k], acc);
#pragma unroll
        for (int k = 0; k < 4; ++k) { fa[k] = na[k]; fb[k] = nb[k]; }
    }
    acc = MFMA32(fa[0], fb[0], acc); acc = MFMA32(fa[1], fb[1], acc);
#undef HY_LDA
#undef HY_LDG
}
struct HyEpi { unsigned long long uu[4], xx[4]; };
DEVFN void hy_epi_load(HyEpi& E, const bf16* ut_seq, const bf16* x0t_seq, int cb, int lane) {
    const int n = lane & 31, h5 = lane >> 5;
#pragma unroll
    for (int g4 = 0; g4 < 4; ++g4) { const int t0 = 32 * (32 * cb + n) + 8 * g4 + 4 * h5; E.uu[g4] = *(const unsigned long long*)(ut_seq + t0); E.xx[g4] = *(const unsigned long long*)(x0t_seq + t0); }
}
DEVFN void hy_wave_store(const f32x16& acc, const HyEpi& E, bf16* yt_seq, float bias, int cb, int lane) {
    const int n = lane & 31, h5 = lane >> 5;
#pragma unroll
    for (int g4 = 0; g4 < 4; ++g4) { const int t0 = 32 * (32 * cb + n) + 8 * g4 + 4 * h5; const unsigned long long uu = E.uu[g4], xx = E.xx[g4];
        float y[4];
#pragma unroll
        for (int k = 0; k < 4; ++k) { const float uv = bf2f((unsigned)((uu >> (16 * k)) & 0xffffu)), xv = bf2f((unsigned)((xx >> (16 * k)) & 0xffffu)); y[k] = xv * (acc[4 * g4 + k] + bias * uv); }
        *(unsigned long long*)(yt_seq + t0) = (unsigned long long)CVTPK(y[0], y[1]) | ((unsigned long long)CVTPK(y[2], y[3]) << 32); }
}
DEVFN void hyena_conv_phase(LAS unsigned char* lds, const bf16* f8, const bf16* f4, const bf16* ut, const bf16* x0t, bf16* yt, const float* hbias, int tid, int bid, int G) {
    const int lane = tid & 63, wave = UNIFORM(tid >> 6);
    constexpr int NP8 = (2 * DEC_SEQ / 8 + 511) / 512, NP4 = (2 * SEQ / 8 + 511) / 512, NCB4 = HyGeom<SEQ>::NCB;
    hy_zero_pads<DEC_SEQ>(lds + HY_UOFF, tid);
    for (int b = 0; b < BATCH; ++b) hy_zero_pads<SEQ>(lds + HY_UOFF2 + b * HyGeom<SEQ>::UBYTES, tid);
    HyFilt<NP8> F8; HyFilt<NP4> F4;
    if (bid < HW) { hy_filter_load<DEC_SEQ, NP8>(F8, f8 + (size_t)bid * 2 * DEC_SEQ, tid); hy_stage_u<DEC_SEQ>(lds + HY_UOFF, ut + (size_t)bid * M + BATCH * SEQ, tid); }
    for (int c = bid; c < HW; c += G) {
        const float bias = hbias[c];
        hy_filter_write<DEC_SEQ, NP8>(lds, F8, tid);
        SYNC();
        hy_filter_load<SEQ, NP4>(F4, f4 + (size_t)c * 2 * SEQ, tid);
        for (int b = 0; b < BATCH; ++b) hy_stage_u<SEQ>(lds + HY_UOFF2 + b * HyGeom<SEQ>::UBYTES, ut + (size_t)c * M + b * SEQ, tid);
        if (wave < HyGeom<DEC_SEQ>::NCB) { f32x16 acc; HyEpi E; hy_epi_load(E, ut + (size_t)c * M + BATCH * SEQ, x0t + (size_t)c * M + BATCH * SEQ, wave, lane);
            hy_wave_conv<DEC_SEQ>(lds + HY_KOFF, lds + HY_UOFF, wave, lane, acc);
            hy_wave_store(acc, E, yt + (size_t)c * M + BATCH * SEQ, bias, wave, lane); }
        SYNC();
        hy_filter_write<SEQ, NP4>(lds, F4, tid);
        SYNC();
        const int cn = c + G;
        if (cn < HW) { hy_filter_load<DEC_SEQ, NP8>(F8, f8 + (size_t)cn * 2 * DEC_SEQ, tid); hy_stage_u<DEC_SEQ>(lds + HY_UOFF, ut + (size_t)cn * M + BATCH * SEQ, tid); }
        if (wave < BATCH * NCB4) { const int sq = wave / NCB4, cb = wave % NCB4; f32x16 acc; HyEpi E; hy_epi_load(E, ut + (size_t)c * M + sq * SEQ, x0t + (size_t)c * M + sq * SEQ, cb, lane);
            hy_wave_conv<SEQ>(lds + HY_KOFF, lds + HY_UOFF2 + sq * HyGeom<SEQ>::UBYTES, cb, lane, acc);
            hy_wave_store(acc, E, yt + (size_t)c * M + sq * SEQ, bias, cb, lane); }
        SYNC();
    }
}
DEVFN void hyena_pre_phase(LAS unsigned char* lds, const bf16* p  , const float* cw  , const float* cb3  , bf16* ut, bf16* x0t, int tid, int bid, int G) {
    constexpr int CB = 64, NU = (M / 128) * (HW / CB);
    LAS unsigned short* tu = (LAS unsigned short*)lds; LAS unsigned short* tx = tu + CB * 136;
    LAS float* Lc = (LAS float*)(lds + 2 * CB * 136 * 2);
    int ckey = -1;
    for (int un = bid; un < NU; un += G) {
        const int m0 = (un / (HW / CB)) * 128, c0 = (un % (HW / CB)) * CB, cg = tid & 7;
        if (ckey != c0) { ckey = c0;
            for (int i = tid; i < 12 * CB; i += 512) { const int jk = i / CB, cc = i % CB, j = jk / 3, k = jk % 3; Lc[i] = j < 3 ? cw[j * (3 * HW) + k * HW + c0 + cc] : cb3[k * HW + c0 + cc]; }
            SYNC(); }
#pragma unroll
        for (int hf = 0; hf < 2; ++hf) { const int r = (tid >> 3) + 64 * hf, m = m0 + r;
            const int row0 = m < BATCH * SEQ ? (m / SEQ) * SEQ : BATCH * SEQ, len = m < BATCH * SEQ ? SEQ : DEC_SEQ, t = m - row0;
            u32x4 tap[3][3];
#pragma unroll
            for (int k = 0; k < 3; ++k)
#pragma unroll
                for (int j = 0; j < 3; ++j) { const int tt = t + j - 1; tap[k][j] = (tt >= 0 && tt < len) ? *(const u32x4*)(p + (size_t)(row0 + tt) * IN_EVEN + k * HW + c0 + 8 * cg) : (u32x4){0u, 0u, 0u, 0u}; }
            float res[3][8];
#pragma unroll
            for (int k = 0; k < 3; ++k) {
                { const f32x4 b0 = *(const LAS f32x4*)(Lc + (9 + k) * CB + 8 * cg), b1 = *(const LAS f32x4*)(Lc + (9 + k) * CB + 8 * cg + 4);
#pragma unroll
                  for (int e = 0; e < 4; ++e) { res[k][e] = b0[e]; res[k][4 + e] = b1[e]; } }
#pragma unroll
                for (int j = 0; j < 3; ++j) { const u32x4 v = tap[k][j]; const f32x4 w0 = *(const LAS f32x4*)(Lc + (j * 3 + k) * CB + 8 * cg), w1 = *(const LAS f32x4*)(Lc + (j * 3 + k) * CB + 8 * cg + 4);
#pragma unroll
                    for (int e = 0; e < 8; ++e) { const unsigned w = v[e >> 1]; res[k][e] += bf2f((e & 1) ? (w >> 16) : (w & 0xffffu)) * (e < 4 ? w0[e & 3] : w1[e & 3]); } } }
#pragma unroll
            for (int e = 0; e < 8; ++e) { tu[(8 * cg + e) * 136 + r] = (unsigned short)f2bf(res[2][e] * res[1][e]); tx[(8 * cg + e) * 136 + r] = (unsigned short)f2bf(res[0][e]); } }
        SYNC();
#pragma unroll
        for (int hf = 0; hf < 2; ++hf) { const int ch = (tid >> 4) + 32 * hf, pc = tid & 15;
          *(u32x4*)(ut + (size_t)(c0 + ch) * M + m0 + 8 * pc) = *(const LAS u32x4*)(tu + ch * 136 + 8 * pc);
          *(u32x4*)(x0t + (size_t)(c0 + ch) * M + m0 + 8 * pc) = *(const LAS u32x4*)(tx + ch * 136 + 8 * pc); }
        SYNC();
    }
}
DEVFN void hyena_post_phase(LAS unsigned char* lds, const bf16* yt, bf16* Y, int tid, int bid, int G) {
    constexpr int CB = 64, NU = (M / 128) * (HW / CB);
    LAS unsigned short* ty = (LAS unsigned short*)lds;
    for (int un = bid; un < NU; un += G) {
        const int m0 = (un / (HW / CB)) * 128, c0 = (un % (HW / CB)) * CB;
        u32x4 v[2];
#pragma unroll
        for (int hf = 0; hf < 2; ++hf) v[hf] = *(const u32x4*)(yt + (size_t)(c0 + (tid >> 4) + 32 * hf) * M + m0 + 8 * (tid & 15));
#pragma unroll
        for (int hf = 0; hf < 2; ++hf) { const int ch = (tid >> 4) + 32 * hf, pc = tid & 15;
#pragma unroll
            for (int e = 0; e < 8; ++e) { const unsigned w = v[hf][e >> 1]; ty[(8 * pc + e) * 72 + ch] = (unsigned short)((e & 1) ? (w >> 16) : (w & 0xffffu)); } }
        SYNC();
#pragma unroll
        for (int hf = 0; hf < 2; ++hf) { const int r = (tid >> 3) + 64 * hf, cg = tid & 7; *(u32x4*)(Y + (size_t)(m0 + r) * D_MODEL + c0 + 8 * cg) = *(const LAS u32x4*)(ty + r * 72 + 8 * cg); }
        SYNC();
    }
}
static_assert(LB == 128 && LRU_BLOCKS == 8, "lru body geometry");
constexpr int LR_T = 64, LR_NCH = M / LR_T;
#ifdef CPU_EMU
#define LRU_FENCE() ((void)0)
#else
#define LRU_FENCE() asm volatile("" ::: "memory")
#endif
constexpr int LR_XT = 0, LR_HS = 16384, LR_WX = 49152, LR_CW = 53248;
template <int PASS> DEVFN void lru_pass(LAS unsigned char* lds, const bf16* p  , const float* cw  , const float* cbv  , const bf16* lwt,
                                        const float* ba, const float* bx, const float* nsp8  , float* agg  , const float* carry  , bf16* Y, int tid, int bid, int G) {
    const int lane = tid & 63, wave = UNIFORM(tid >> 6), cg = wave & 3, rt = wave >> 2, l31 = lane & 31, h5 = lane >> 5;
    LAS float* Lh = (LAS float*)(lds + LR_HS); LAS float* Lw = (LAS float*)(lds + LR_WX);
    const int n = bid % LRU_BLOCKS, GB = G / LRU_BLOCKS;
    bf16x8 fr[8], fi[8];
#define LRU_LOADW(dir_) do { const bf16* wr_ = lwt + ((size_t)((dir_) * 2 + 0) * LRU_BLOCKS + n) * LB * LB + (size_t)(32 * cg + l31) * LB + 8 * h5; const bf16* wi_ = wr_ + (size_t)LRU_BLOCKS * LB * LB; \
        _Pragma("unroll") for (int ks = 0; ks < 8; ++ks) { fr[ks] = *(const bf16x8*)(wr_ + 16 * ks); fi[ks] = *(const bf16x8*)(wi_ + 16 * ks); } } while (0)
    LRU_LOADW(0);
    float gba[2], gbx[2], gns[2];
#pragma unroll
    for (int dir = 0; dir < 2; ++dir) { const int c = n * LB + 32 * cg + l31; gba[dir] = ba[dir * LW + c]; gbx[dir] = bx[dir * LW + c]; gns[dir] = nsp8[dir * LW + c]; }
    LAS float* Lc = (LAS float*)(lds + LR_CW);
    if (tid < LB) {
#pragma unroll
        for (int j = 0; j < 4; ++j) Lc[j * LB + tid] = cw[j * LW + n * LB + tid];
        Lc[4 * LB + tid] = cbv[n * LB + tid]; }
    u32x4 tap[2][4];
#define LRU_LOADTAPS(chunk_) do { const int m0_ = (chunk_) * LR_T, row0_ = m0_ < BATCH * SEQ ? (m0_ / SEQ) * SEQ : BATCH * SEQ, len_ = m0_ < BATCH * SEQ ? SEQ : DEC_SEQ, t_ = m0_ + (tid >> 3) - row0_; \
        _Pragma("unroll") for (int q = 0; q < 2; ++q) _Pragma("unroll") for (int j = 0; j < 4; ++j) { const int tt = t_ + j - 2; \
            tap[q][j] = (tt >= 0 && tt < len_) ? *(const u32x4*)(p + (size_t)(row0_ + tt) * IN_EVEN + 3 * HW + LW + n * LB + 8 * ((tid & 7) * 2 + q)) : (u32x4){0u, 0u, 0u, 0u}; } } while (0)
    const int chunk0 = bid / LRU_BLOCKS; const bool active = bid < GB * LRU_BLOCKS;
    if (active && chunk0 < LR_NCH) LRU_LOADTAPS(chunk0);
    SYNC();
    for (int chunk = chunk0; chunk < LR_NCH && active; chunk += GB) {
        const int m0 = chunk * LR_T;
        int tid_i = tid; OPAQUE_V(tid_i); const int l31 = tid_i & 31, h5 = (tid_i >> 5) & 1;
        { const int r = tid_i >> 3;
#pragma unroll
          for (int q = 0; q < 2; ++q) { const int ch = (tid_i & 7) * 2 + q; float x[8];
              { const f32x4 b0 = *(const LAS f32x4*)(Lc + 4 * LB + 8 * ch), b1 = *(const LAS f32x4*)(Lc + 4 * LB + 8 * ch + 4);
#pragma unroll
                for (int e = 0; e < 4; ++e) { x[e] = b0[e]; x[4 + e] = b1[e]; } }
#pragma unroll
              for (int j = 0; j < 4; ++j) { const u32x4 v = tap[q][j]; const f32x4 w0 = *(const LAS f32x4*)(Lc + j * LB + 8 * ch), w1 = *(const LAS f32x4*)(Lc + j * LB + 8 * ch + 4);
#pragma unroll
                  for (int e = 0; e < 8; ++e) { const unsigned w = v[e >> 1]; x[e] += bf2f((e & 1) ? (w >> 16) : (w & 0xffffu)) * (e < 4 ? w0[e & 3] : w1[e & 3]); } }
              *(LAS u32x4*)(lds + LR_XT + off_b(r, ch)) = (u32x4){CVTPK(x[0], x[1]), CVTPK(x[2], x[3]), CVTPK(x[4], x[5]), CVTPK(x[6], x[7])}; } }
        if (chunk + GB < LR_NCH) LRU_LOADTAPS(chunk + GB);
        float c0v[2]; u32x4 pgv[2];
        if (PASS == 2) {
#pragma unroll
            for (int dir = 0; dir < 2; ++dir) c0v[dir] = carry[((size_t)dir * LR_NCH + chunk) * LW + n * LB + 32 * cg + l31];
#pragma unroll
            for (int q = 0; q < 2; ++q) pgv[q] = *(const u32x4*)(p + (size_t)(m0 + (tid_i >> 3)) * IN_EVEN + 3 * HW + n * LB + 8 * ((tid_i & 7) * 2 + q)); }
        SYNC();
        const int cl = 32 * cg + l31, c = n * LB + cl;
        float hsum[16];
#pragma unroll
        for (int dir = 0; dir < 2; ++dir) {
            f32x16 av, bv;
#pragma unroll
            for (int r = 0; r < 16; ++r) { av[r] = 0.f; bv[r] = 0.f; }
#pragma unroll
            for (int ks = 0; ks < 8; ++ks) { const bf16x8 xf = *(const LAS bf16x8*)(lds + LR_XT + off_b(32 * rt + l31, 2 * ks + h5)); av = MFMA32(xf, fr[ks], av); bv = MFMA32(xf, fi[ks], bv); }
            LRU_LOADW(dir ^ 1);
            { const float bav = gba[dir], bxv = gbx[dir], nsp = gns[dir];
#pragma unroll
              for (int r = 0; r < 16; ++r) { const int t = 32 * rt + (r & 3) + 8 * (r >> 2) + 4 * h5;
                  const float rr = RCP(1.0f + EXP2(-1.4426950408889634f * (av[r] + bav))), ii = RCP(1.0f + EXP2(-1.4426950408889634f * (bv[r] + bxv)));
                  const float la = nsp * rr, a_ = EXP2(1.4426950408889634f * la);
                  const float xbv = bf2f(*(const LAS unsigned short*)(lds + LR_XT + off_b(t, cl >> 3) + 2 * (cl & 7)));
                  av[r] = a_; bv[r] = sqrtf(fmaxf(1.0f - a_ * a_, 0.f)) * (ii * xbv); } }
            float sP[4], sH[4];
#pragma unroll
            for (int j = 0; j < 4; ++j) { float P = 1.f, H = 0.f;
#pragma unroll
                for (int qq = 0; qq < 4; ++qq) { const int r = 4 * j + (dir ? 3 - qq : qq); H = av[r] * H + bv[r]; P *= av[r]; }
                sP[j] = P; sH[j] = H; }
            float oP[4], oH[4];
#pragma unroll
            for (int j = 0; j < 4; ++j) { oP[j] = bperm_f(((tid_i & 63) ^ 32) << 2, sP[j]); oH[j] = bperm_f(((tid_i & 63) ^ 32) << 2, sH[j]); }
            const bool first = dir ? (h5 == 1) : (h5 == 0);
            float pP[4], pH[4];
#pragma unroll
            for (int j = 0; j < 4; ++j) { const float P1 = first ? sP[j] : oP[j], H1 = first ? sH[j] : oH[j], P2 = first ? oP[j] : sP[j], H2 = first ? oH[j] : sH[j]; pP[j] = P2 * P1; pH[j] = P2 * H1 + H2; }
            float wP = 1.f, wH = 0.f;
#pragma unroll
            for (int jj = 0; jj < 4; ++jj) { const int j = dir ? 3 - jj : jj; wH = pP[j] * wH + pH[j]; wP *= pP[j]; }
            if (h5 == 0) { LAS float* w = Lw + ((dir * 2 + rt) * LB + cl) * 2; w[0] = wP; w[1] = wH; }
            SYNC();
            const LAS float* wo = Lw + ((dir * 2 + (rt ^ 1)) * LB + cl) * 2; const float xP = wo[0], xH = wo[1];
            const bool wfirst = dir ? (rt == 1) : (rt == 0);
            if (PASS == 1) { if (!wfirst && h5 == 0) { float* ag = agg + (((size_t)dir * LR_NCH + chunk) * LW + c) * 2; ag[0] = wP * xP; ag[1] = wP * xH + wH; } }
            else { const float c0 = c0v[dir]; float cj = wfirst ? c0 : xP * c0 + xH;
#pragma unroll
                for (int jj = 0; jj < 4; ++jj) { const int j = dir ? 3 - jj : jj; float h = first ? cj : oP[j] * cj + oH[j];
#pragma unroll
                    for (int qq = 0; qq < 4; ++qq) { const int r = 4 * j + (dir ? 3 - qq : qq); h = av[r] * h + bv[r]; if (dir == 0) hsum[r] = h; else hsum[r] += h; }
                    cj = pP[j] * cj + pH[j]; } }
        }
        if (PASS == 2) {
#pragma unroll
            for (int r = 0; r < 16; ++r) Lh[(32 * rt + (r & 3) + 8 * (r >> 2) + 4 * h5) * LB + cl] = hsum[r];
            SYNC();
            const int r = tid_i >> 3;
#pragma unroll
            for (int q = 0; q < 2; ++q) { const int ch = (tid_i & 7) * 2 + q, c = n * LB + 8 * ch; const u32x4 v = pgv[q]; float y[8];
#pragma unroll
                for (int e = 0; e < 8; ++e) { const unsigned w = v[e >> 1]; const float xg = bf2f((e & 1) ? (w >> 16) : (w & 0xffffu)), ug = 0.7978845608028654f * (xg + 0.044715f * xg * xg * xg);
                    y[e] = Lh[r * LB + 8 * ch + e] * xg * RCP(1.0f + EXP2(-2.0f * 1.4426950408889634f * ug)); }
                *(u32x4*)(Y + (size_t)(m0 + r) * D_MODEL + HW + c) = (u32x4){CVTPK(y[0], y[1]), CVTPK(y[2], y[3]), CVTPK(y[4], y[5]), CVTPK(y[6], y[7])}; }
        }
    }
    SYNC();
#undef LRU_LOADW
#undef LRU_LOADTAPS
}
DEVFN void lru_carry_item(const float* agg, float* carry, int item) {
    const int c = item % LW, sq = (item / LW) % (BATCH + 1), dir = item / (LW * (BATCH + 1));
    const int ch0 = (sq < BATCH ? sq * SEQ : BATCH * SEQ) / LR_T, nch = (sq < BATCH ? SEQ : DEC_SEQ) / LR_T;
    float h = 0.f;
    for (int kb = 0; kb < nch; kb += 8) { float pa[8], pb[8];
#pragma unroll
        for (int k = 0; k < 8; ++k) { const int ch = ch0 + (dir ? nch - 1 - (kb + k) : kb + k); const float* ag = agg + (((size_t)dir * LR_NCH + ch) * LW + c) * 2; pa[k] = ag[0]; pb[k] = ag[1]; }
#pragma unroll
        for (int k = 0; k < 8; ++k) { const int ch = ch0 + (dir ? nch - 1 - (kb + k) : kb + k); carry[((size_t)dir * LR_NCH + ch) * LW + c] = h; h = pa[k] * h + pb[k]; } }
}
static_assert(SEQ % 64 == 0 && DEC_SEQ % 64 == 0 && HW % 64 == 0, "filter expansion geometry");
#ifdef CPU_EMU
#define FX_FENCE() ((void)0)
#else
#define FX_FENCE() asm volatile("" ::: "memory")
#endif
constexpr int FX_LS = 80;
constexpr int FX_CD = (HW / 64) * 2, FX_PT = FILT_T / 64, FX_UNITS = N_EVEN * FX_CD * FX_PT;
DEVFN void filter_expand_phase(LAS unsigned char* lds, const float* h2all  , const float* woutall  , bf16* fl0, bf16* fl1  , int tid, int bid, int G) {
    const int cl = tid & 63, tg = UNIFORM(tid >> 6);
    LAS unsigned short* tile = (LAS unsigned short*)lds;
    LAS float* hs = (LAS float*)(lds + 16384);
    LAS float* wsm = (LAS float*)(lds + 16384 + 64 * FX_LS * 4);
    int wkey = -1;
    f32x4 hv[2];
#define FX_LOADH(un_) do { const int cd_ = (un_) % FX_CD, pt_ = (un_) / FX_CD, jj_ = pt_ / FX_PT, ttb_ = pt_ % FX_PT; const bool big_ = ttb_ >= SEQ / 64; \
        const int L_ = big_ ? DEC_SEQ : SEQ, base_ = big_ ? SEQ : 0, pos0_ = (big_ ? ttb_ - SEQ / 64 : ttb_) * 64 + (cd_ & 1); \
        _Pragma("unroll") for (int r = 0; r < 2; ++r) { const int idx = tid + 512 * r, pos = pos0_ + (idx >> 4); \
            hv[r] = *(const f32x4*)(h2all + (size_t)jj_ * FILT_T * FO + (size_t)(base_ + (pos < L_ ? pos : L_ - 1)) * FO + 4 * (idx & 15)); } } while (0)
    if (bid < FX_UNITS) FX_LOADH(bid);
    for (int un = bid; un < FX_UNITS; un += G) {
        const int cd = un % FX_CD, pt = un / FX_CD, jj = pt / FX_PT, ttb = pt % FX_PT, dir = cd & 1, c0 = (cd >> 1) * 64;
        const bool big = ttb >= SEQ / 64; const int L = big ? DEC_SEQ : SEQ, pos0 = (big ? ttb - SEQ / 64 : ttb) * 64 + dir;
        if (wkey != jj * FX_CD + cd) { wkey = jj * FX_CD + cd; const float* wt = woutall + (size_t)jj * FO * 2 * HW + dir * HW + c0;
#pragma unroll
            for (int r = 0; r < 8; ++r) { const int idx = tid + 512 * r, q = idx >> 6, c = idx & 63; wsm[q * FX_LS + c] = wt[(size_t)q * 2 * HW + c]; } }
#pragma unroll
        for (int r = 0; r < 2; ++r) { const int idx = tid + 512 * r, pi = idx >> 4, q4 = idx & 15; const f32x4 v = hv[r];
            hs[(4 * q4 + 0) * FX_LS + pi] = v[0]; hs[(4 * q4 + 1) * FX_LS + pi] = v[1]; hs[(4 * q4 + 2) * FX_LS + pi] = v[2]; hs[(4 * q4 + 3) * FX_LS + pi] = v[3]; }
        if (un + G < FX_UNITS) FX_LOADH(un + G);
        SYNC();
        { const int lane = tid & 63, l15 = lane & 15, l4 = lane >> 4, cb = tg & 3, pbw = tg >> 2;
          f32x4 acc[2] = {{0.f, 0.f, 0.f, 0.f}, {0.f, 0.f, 0.f, 0.f}};
          const LAS float* hp = hs + l4 * FX_LS + 32 * pbw + l15; const LAS float* wp = wsm + l4 * FX_LS + 16 * cb + l15;
#pragma unroll 4
          for (int ks = 0; ks < FO / 4; ++ks) { const float b = wp[4 * ks * FX_LS], a0 = hp[4 * ks * FX_LS], a1 = hp[4 * ks * FX_LS + 16];
              acc[0] = MFMA16F32(a0, b, acc[0]); acc[1] = MFMA16F32(a1, b, acc[1]); }
          const int chl = 16 * cb + l15;
          const float la = -4.605170185988091f / 1.5f, lb = -4.605170185988091f / 0.3f;
          const float delta = fabsf(la + (lb - la) * (float)(c0 + chl) / (float)(HW - 1)), inv = 1.0f / (float)(L - 1 > 1 ? L - 1 : 1);
#pragma unroll
          for (int sb = 0; sb < 2; ++sb) { const int posl = 32 * pbw + 16 * sb + 4 * l4; unsigned short e[4];
#pragma unroll
              for (int r = 0; r < 4; ++r) { const int pos = pos0 + posl + r; e[r] = (unsigned short)f2bf(pos < L ? acc[sb][r] * expf(-((float)pos * inv) * delta) : 0.f); }
              *(LAS unsigned*)(tile + chl * 72 + posl) = (unsigned)e[0] | ((unsigned)e[1] << 16); *(LAS unsigned*)(tile + chl * 72 + posl + 2) = (unsigned)e[2] | ((unsigned)e[3] << 16); } }
        SYNC();
        { const int c = tid >> 3, pc = tid & 7; bf16* fl = jj ? fl1 : fl0; bf16* f = big ? fl + (size_t)(c0 + c) * 2 * DEC_SEQ : fl + (size_t)HW * 2 * DEC_SEQ + (size_t)(c0 + c) * 2 * SEQ;
          unsigned short e[8];
          if (dir == 0) {
#pragma unroll
              for (int i = 0; i < 8; ++i) e[i] = tile[c * 72 + 63 - 8 * pc - i];
              *(u32x4*)(f + L - 64 - pos0 + 8 * pc) = (u32x4){(unsigned)e[0] | ((unsigned)e[1] << 16), (unsigned)e[2] | ((unsigned)e[3] << 16), (unsigned)e[4] | ((unsigned)e[5] << 16), (unsigned)e[6] | ((unsigned)e[7] << 16)};
          } else {
#pragma unroll
              for (int i = 0; i < 8; ++i) e[i] = tile[c * 72 + 8 * pc + i];
              *(u32x4*)(f + L - 1 + pos0 + 8 * pc) = (u32x4){(unsigned)e[0] | ((unsigned)e[1] << 16), (unsigned)e[2] | ((unsigned)e[3] << 16), (unsigned)e[4] | ((unsigned)e[5] << 16), (unsigned)e[6] | ((unsigned)e[7] << 16)};
          } }
        SYNC();
    }
#undef FX_LOADH
}
namespace pg8 {
struct EpiQKVRopeWs {
    static constexpr bool PERM = true, AFTER_DRAIN = false;
    unsigned char* ws; int ninst, jodd;
    __device__ __forceinline__ void operator()(const f32x4 (&acc)[2][2][4][2], const Unit& u, int wr, int wc, int fr, int fq) const {
        const EpiQKVRope e{(bf16_t*)(ws + WS_G), QKV_N, (const pg8::rowss_t*)(ws + WS_ROWSS) + (size_t)ninst * M, (const float*)(ws + WS_ROPE), 0.125f * 1.4426950408889634f, (unsigned*)(ws + WS_KMAX) + (size_t)jodd * KMAX_LAYER};
        e(acc, u, wr, wc, fr, fq);
    }
};
}
__device__ __forceinline__ int probe_reps(int n) { asm volatile("" : "+s"(n)); return n; }
__global__ void __launch_bounds__(NTHREADS, 2) enc_fwd(Args args) {
    extern __shared__ __attribute__((aligned(16))) unsigned char lds[];
    LAS unsigned char* const L = (LAS unsigned char*)lds;
    volatile LAS unsigned* MISC = (volatile LAS unsigned*)(L + MISC_OFF);
    for (int u = threadIdx.x; u < (LDS_BYTES - LDSCTL_OFF) / 4; u += NTHREADS) ((LAS unsigned*)(L + LDSCTL_OFF))[u] = 0u;
    __syncthreads();
    XcdBarrier bar = xcd_barrier_post((unsigned*)(args.ws + WS_CTL) + CW_BAR, MISC + 8);
    const int lo = args.ph_lo, hi = args.ph_hi;
    const int wave0 = __builtin_amdgcn_readfirstlane((int)threadIdx.x >> 6);
#define PHASE(k) if (lo <= (k) && (k) < hi)
#define ENTER() const Frame F = make_frame(L, wave0); const CArgs* const ap = opaque_args(); const CArgs& A = *ap; unsigned char* const ws = A.ws; float* const X = A.out; \
    bf16* const H = (bf16*)(ws + WS_H); bf16* const Gb = (bf16*)(ws + WS_G); bf16* const Y = (bf16*)(ws + WS_Y); (void)F; (void)X; (void)H; (void)Gb; (void)Y
#define SEAM(k) do { if ((k) + 1 < hi) xcd_barrier(bar); } while (0)
#ifdef PROBE_TAG
#define REP(tag) for (int rep_ = 0, nrep_ = (PROBE_TAG == (tag)) ? probe_reps(2) : 1; rep_ < nrep_; ++rep_)
#else
#define REP(tag)
#endif

    PHASE(PH_PRO0) { ENTER(); REP(1) phase_prologue0(F, A); SEAM(PH_PRO0); }
    PHASE(PH_PRO3) { ENTER();
        REP(13) filter_expand_phase(F.lds + RING_OFF, (const float*)(ws + WS_FH) + (size_t)2 * N_EVEN * FILT_T * FO, A.in[15], (bf16*)(ws + ws_filt(0)), (bf16*)(ws + ws_filt(1)), F.tid, F.bid, F.G);
        SEAM(PH_PRO3); }

    for (int l = 0; l < DEPTH; ++l) {
        const int pb = PH_LAYER0 + l * PH_PER_LAYER, j = l >> 1;
        PHASE(pb + 1) { ENTER(); const pg8::rowss_t* rss = (const pg8::rowss_t*)(ws + WS_ROWSS) + (size_t)(3 * l + 0) * M; pg8::Gemm g{H, (const bf16*)(ws + WS_WUP + (size_t)(l * 2 + 0) * UP_BYTES), M, UP_N, D_MODEL}; pg8::StaticOrder S; S.init(M, UP_N, F.G, F.bid);
            pg8::EpiSwiGLUNorm E{Gb, D_FF, rss}; REP(2) pg8::gemm_phase<pg8::EpiSwiGLUNorm, pg8::StaticOrder, true, true>(F.lds + RING_OFF, g, S, E, F.tid); SEAM(pb + 1); }
        PHASE(pb + 2) { ENTER(); pg8::Gemm g{Gb, (const bf16*)(ws + WS_WDN + (size_t)(l * 2 + 0) * DN_BYTES), M, D_MODEL, D_FF}; pg8::StaticOrder S; S.init(M, D_MODEL, F.G, F.bid);
            pg8::EpiResidNorm E{X, H, (pg8::rowss_t*)(ws + WS_ROWSS) + (size_t)(3 * l + 1) * M, D_MODEL, 0.5f}; pg8::gemm_phase<pg8::EpiResidNorm, pg8::StaticOrder, false, true, true, false>(F.lds + RING_OFF, g, S, E, F.tid); SEAM(pb + 2); }
        if (!(l & 1)) {
            PHASE(pb + 4) { ENTER(); pg8::Gemm g{H, (const bf16*)(ws + WS_WEIN + (size_t)j * EIN_BYTES), M, IN_EVEN, D_MODEL}; pg8::StaticOrder S; S.init(M, IN_EVEN, F.G, F.bid);
                pg8::EpiBf16Norm E{Gb, IN_EVEN, (const pg8::rowss_t*)(ws + WS_ROWSS) + (size_t)(3 * l + 1) * M}; REP(10) pg8::gemm_phase<pg8::EpiBf16Norm, pg8::StaticOrder, true, true>(F.lds + RING_OFF, g, S, E, F.tid); SEAM(pb + 4); }
            PHASE(pb + 5) { ENTER();
                REP(9) hyena_pre_phase(F.lds + RING_OFF, Gb, A.in[9] + (size_t)j * 9 * HW, A.in[10] + (size_t)j * 3 * HW, (bf16*)(ws + WS_UT), (bf16*)(ws + WS_X0T), F.tid, F.bid, F.G);
                REP(8) lru_pass<1>(F.lds + RING_OFF, Gb, A.in[17] + (size_t)j * 4 * LW, A.in[18] + (size_t)j * LW, (const bf16*)(ws + WS_LWT) + (size_t)j * LWT_LAYER,
                            A.in[20] + (size_t)j * 2 * LW, A.in[22] + (size_t)j * 2 * LW, (const float*)(ws + WS_NSP) + (size_t)j * 2 * LW, (float*)(ws + WS_AGG), (const float*)(ws + WS_CARRY), Y, F.tid, F.bid, F.G);
                SEAM(pb + 5); }
            PHASE(pb + 6) { ENTER();
                for (int i = F.gtid; i < 2 * (BATCH + 1) * LW; i += F.gsize) lru_carry_item((const float*)(ws + WS_AGG), (float*)(ws + WS_CARRY), i);
                REP(4) hyena_conv_phase(F.lds + RING_OFF, (const bf16*)(ws + ws_filt(j)), (const bf16*)(ws + ws_filt(j) + F8_BYTES), (const bf16*)(ws + WS_UT), (const bf16*)(ws + WS_X0T), (bf16*)(ws + WS_YT), A.in[16] + (size_t)j * HW, F.tid, F.bid, F.G);
                SEAM(pb + 6); }
            PHASE(pb + 7) { ENTER();
                REP(11) lru_pass<2>(F.lds + RING_OFF, Gb, A.in[17] + (size_t)j * 4 * LW, A.in[18] + (size_t)j * LW, (const bf16*)(ws + WS_LWT) + (size_t)j * LWT_LAYER,
                            A.in[20] + (size_t)j * 2 * LW, A.in[22] + (size_t)j * 2 * LW, (const float*)(ws + WS_NSP) + (size_t)j * 2 * LW, (float*)(ws + WS_AGG), (const float*)(ws + WS_CARRY), Y, F.tid, F.bid, F.G);
                REP(12) hyena_post_phase(F.lds + RING_OFF, (const bf16*)(ws + WS_YT), Y, F.tid, F.bid, F.G);
                SEAM(pb + 7); }
            PHASE(pb + 11) { ENTER(); pg8::Gemm g{Y, (const bf16*)(ws + WS_WEOUT + (size_t)j * SQ_BYTES), M, D_MODEL, D_MODEL}; pg8::StaticOrder S; S.init(M, D_MODEL, F.G, F.bid);
                pg8::EpiResidNorm E{X, H, (pg8::rowss_t*)(ws + WS_ROWSS) + (size_t)(3 * l + 2) * M, D_MODEL, 1.0f}; pg8::gemm_phase<pg8::EpiResidNorm, pg8::StaticOrder, false, true>(F.lds + RING_OFF, g, S, E, F.tid); SEAM(pb + 11); }
        } else {
            PHASE(pb + 4) { ENTER(); pg8::Gemm g{H, (const bf16*)(ws + WS_WQKV + (size_t)j * QKVW_BYTES), M, QKV_N, D_MODEL}; pg8::StaticOrder S; S.init(M, QKV_N, F.G, F.bid);
                pg8::EpiQKVRopeWs E{ws, 3 * l + 1, j}; REP(10) pg8::gemm_phase<pg8::EpiQKVRopeWs, pg8::StaticOrder, true, true>(F.lds + RING_OFF, g, S, E, F.tid); SEAM(pb + 4); }
            PHASE(pb + 6) { ENTER();
                const float lam = attn_lambda_of(A.in[26] + (size_t)j * 4 * DH, l), omli = 1.0f - lambda_init_of(l);
                REP(3) attn_phase(F.lds + RING_OFF, Gb, Y, A.in[27] + (size_t)j * DV, (const unsigned*)(ws + WS_KMAX) + (size_t)j * KMAX_LAYER, lam, omli, F.tid, F.bid, F.G);
                SEAM(pb + 6); }
            PHASE(pb + 11) { ENTER(); pg8::Gemm g{Y, (const bf16*)(ws + WS_WWO + (size_t)j * SQ_BYTES), M, D_MODEL, D_MODEL}; pg8::StaticOrder S; S.init(M, D_MODEL, F.G, F.bid);
                pg8::EpiResidNorm E{X, H, (pg8::rowss_t*)(ws + WS_ROWSS) + (size_t)(3 * l + 2) * M, D_MODEL, 1.0f}; pg8::gemm_phase<pg8::EpiResidNorm, pg8::StaticOrder, false, true>(F.lds + RING_OFF, g, S, E, F.tid); SEAM(pb + 11); }
        }
        PHASE(pb + 13) { ENTER(); const pg8::rowss_t* rss = (const pg8::rowss_t*)(ws + WS_ROWSS) + (size_t)(3 * l + 2) * M; pg8::Gemm g{H, (const bf16*)(ws + WS_WUP + (size_t)(l * 2 + 1) * UP_BYTES), M, UP_N, D_MODEL}; pg8::StaticOrder S; S.init(M, UP_N, F.G, F.bid);
            pg8::EpiSwiGLUNorm E{Gb, D_FF, rss}; REP(2) pg8::gemm_phase<pg8::EpiSwiGLUNorm, pg8::StaticOrder, true, true>(F.lds + RING_OFF, g, S, E, F.tid); SEAM(pb + 13); }
        PHASE(pb + 14) { ENTER(); pg8::Gemm g{Gb, (const bf16*)(ws + WS_WDN + (size_t)(l * 2 + 1) * DN_BYTES), M, D_MODEL, D_FF}; pg8::StaticOrder S; S.init(M, D_MODEL, F.G, F.bid);
            pg8::EpiResidNorm E{X, H, (pg8::rowss_t*)(ws + WS_ROWSS) + (size_t)(3 * l + 3) * M, D_MODEL, 0.5f}; pg8::gemm_phase<pg8::EpiResidNorm, pg8::StaticOrder, false, true, true, false>(F.lds + RING_OFF, g, S, E, F.tid); SEAM(pb + 14); }
    }
    PHASE(PH_FINAL) { ENTER();
        const pg8::rowss_t* rss = (const pg8::rowss_t*)(ws + WS_ROWSS) + (size_t)(3 * DEPTH) * M; const f32x4* gr = (const f32x4*)A.in[7];
        for (int i = F.gtid; i < M * (D_MODEL / 4); i += F.gsize) { const int m = i / (D_MODEL / 4), c4 = i % (D_MODEL / 4); const float rs = 1.0f / sqrtf((float)rss[m] * (1.0f / (pg8::ROWSS_SCALE * D_MODEL)) + NORM_EPS);
            f32x4* xp = (f32x4*)X + i; const f32x4 v = *xp, gg = gr[c4]; *xp = (f32x4){v.x * rs * gg.x, v.y * rs * gg.y, v.z * rs * gg.z, v.w * rs * gg.w}; } }
#undef PHASE
#undef ENTER
#undef SEAM
}

#ifndef MK_PER_PHASE
#define MK_PER_PHASE 0
#endif
extern "C" void kernel_launch(void* const* d_in, const int* in_sizes, int n_in, void* d_out, int out_size, void* d_ws, size_t ws_size, hipStream_t stream) {
    static int grid = 0;
    if (grid == 0) {
        if (n_in != 29 || out_size != M * D_MODEL || ws_size < WS_END) { fprintf(stderr, "kernel_launch: built for 29 inputs, %d outputs, >= %zu bytes of workspace; got n_in %d, out %d, ws %zu; nothing launched\n", M * D_MODEL, (size_t)WS_END, n_in, out_size, ws_size); grid = -1; return; }
        int dev = 0, cus = 0, per_cu = 0;
        if (hipGetDevice(&dev) != hipSuccess || hipDeviceGetAttribute(&cus, hipDeviceAttributeMultiprocessorCount, dev) != hipSuccess) { grid = -1; return; }
        if (hipFuncSetAttribute((const void*)enc_fwd, hipFuncAttributeMaxDynamicSharedMemorySize, LDS_BYTES) != hipSuccess) { fprintf(stderr, "kernel_launch: hipFuncSetAttribute failed\n"); grid = -1; return; }
        if (hipOccupancyMaxActiveBlocksPerMultiprocessor(&per_cu, (const void*)enc_fwd, NTHREADS, LDS_BYTES) != hipSuccess || per_cu < 1) fprintf(stderr, "kernel_launch: occupancy query reports %d workgroups per CU\n", per_cu);
        (void)hipGetLastError();
        grid = cus;
    }
    if (grid < 0) return;
    if (hipMemsetAsync((char*)d_ws + WS_CTL, 0, ZERO_BYTES, stream) != hipSuccess) return;
    Args a{};
    for (int i = 0; i < 29; ++i) a.in[i] = (const float*)d_in[i];
    a.out = (float*)d_out; a.ws = (unsigned char*)d_ws;
#if MK_PER_PHASE
    for (int k = 0; k < NPHASES; ++k) { if (!phase_exists(k)) continue; a.ph_lo = k; a.ph_hi = k + 1; hipLaunchKernelGGL(enc_fwd, dim3(grid), dim3(NTHREADS), LDS_BYTES, stream, a); }
#else
    a.ph_lo = 0; a.ph_hi = NPHASES; hipLaunchKernelGGL(enc_fwd, dim3(grid), dim3(NTHREADS), LDS_BYTES, stream, a);
#endif
}
#endif
```

```cpp
#ifdef CPU_TEST
#include <cmath>
#include <cstdint>
#include <cstddef>
#define HD inline
#else
#include <hip/hip_runtime.h>
#include <cstdio>
#include <cstdint>
#define HD __host__ __device__ __forceinline__
#endif

#if defined(CFG_SMALL)
constexpr int D_MODEL = 256, BATCH = 2, SEQ = 64, DEPTH = 4, DEC_SEQ = 128, D_FF = 512, ATT_HEADS = 2;
#elif defined(CFG_EMU)
constexpr int D_MODEL = 256, BATCH = 2, SEQ = 128, DEPTH = 4, DEC_SEQ = 256, D_FF = 512, ATT_HEADS = 2;
#else
constexpr int D_MODEL = 2048, BATCH = 2, SEQ = 4096, DEPTH = 4, DEC_SEQ = 8192, D_FF = 5632, ATT_HEADS = 16;
#endif
constexpr int M = BATCH * SEQ + DEC_SEQ;
constexpr int N_EVEN = (DEPTH + 1) / 2, N_ODD = DEPTH / 2;
constexpr int HW = D_MODEL / 2, LW = D_MODEL / 2, IN_EVEN = 3 * HW + 2 * LW;
constexpr int FO = 64, EMB = 33, BANDS = 16;
constexpr int LRU_BLOCKS = 8, LB = LW / LRU_BLOCKS;
constexpr int DH = D_MODEL / (2 * ATT_HEADS), DV = 2 * DH;
constexpr int QKV_N = 3 * D_MODEL, UP_N = 2 * D_FF;
constexpr float NORM_EPS = 1e-6f;
constexpr int FILT_T = SEQ + DEC_SEQ;

#if defined(CPU_TEST) && defined(NO_BF16)
typedef float bf16;
HD float f2bf(float f) { return f; }
HD float bf2f(float b) { return b; }
#else
typedef unsigned short bf16;
HD unsigned f2bf(float f) { unsigned u; __builtin_memcpy(&u, &f, 4); return (u + 0x7fffu + ((u >> 16) & 1u)) >> 16; }
HD float bf2f(unsigned b) { unsigned u = b << 16; float f; __builtin_memcpy(&f, &u, 4); return f; }
#endif

struct SeqInfo { int row0, len; };
HD SeqInfo seq_of_row(int m) { SeqInfo s; if (m < BATCH * SEQ) { s.row0 = (m / SEQ) * SEQ; s.len = SEQ; } else { s.row0 = BATCH * SEQ; s.len = DEC_SEQ; } return s; }
HD float sigmoidf_(float x) { return 1.0f / (1.0f + expf(-x)); }
HD float softplusf_(float x) { return x > 20.f ? x : log1pf(expf(x)); }
HD float gelu_tanhf_(float x) { return 0.5f * x * (1.0f + tanhf(0.7978845608028654f * (x + 0.044715f * x * x * x))); }
HD float lambda_init_of(int layer) { return 0.8f - 0.6f * expf(-0.3f * (float)layer); }

HD void filt_pos(int tt, int& L, int& pos) { if (tt < SEQ) { L = SEQ; pos = tt; } else { L = DEC_SEQ; pos = tt - SEQ; } }
HD float el_filt_h0(const float* w_in  , const float* b  , const float* freq  , int tt, int q) {
    int L, pos; filt_pos(tt, L, pos);
    const float fp = (float)pos, tn = fp / (float)(L - 1 > 1 ? L - 1 : 1), w = (6.283185307179586f / (float)L) * fp;
    float acc = b[q] + tn * w_in[q];
    for (int e = 0; e < BANDS; ++e) { const float band = 1e-4f + (float)e * ((float)(BANDS - 1) - 1e-4f) / (float)(BANDS - 1);
        acc += cosf(band * w) * w_in[(1 + e) * FO + q] - sinf(band * w) * w_in[(1 + BANDS + e) * FO + q]; }
    return sinf(freq[q] * acc);
}
HD float el_filt_hid(const float* hprev_row  , const float* w_hid  , const float* bias  , const float* freq, int q) {
    float acc = bias[q];
    for (int r = 0; r < FO; ++r) acc += hprev_row[r] * w_hid[r * FO + q];
    return sinf(freq[q] * acc);
}
HD float el_filt_out(const float* h2_row, const float* w_out  , int tt, int dir, int c) {
    int L, pos; filt_pos(tt, L, pos);
    const float tn = (float)pos / (float)(L - 1 > 1 ? L - 1 : 1);
    const float la = -4.605170185988091f / 1.5f, lb = -4.605170185988091f / 0.3f;
    const float delta = fabsf(la + (lb - la) * (float)c / (float)(HW - 1));
    float acc = 0.f;
    for (int q = 0; q < FO; ++q) acc += h2_row[q] * w_out[q * (2 * HW) + dir * HW + c];
    return acc * expf(-tn * delta);
}

HD void el_hyena_pre(const bf16* p  , const float* cw  , const float* cb  , int m, int c, float& u, float& x0) {
    const SeqInfo s = seq_of_row(m); const int t = m - s.row0; float r[3];
    for (int k = 0; k < 3; ++k) { const int col = k * HW + c; float acc = cb[col];
        for (int j = 0; j < 3; ++j) { const int tt = t + j - 1; if (tt >= 0 && tt < s.len) acc += bf2f(p[(size_t)(s.row0 + tt) * IN_EVEN + col]) * cw[j * (3 * HW) + col]; }
        r[k] = acc; }
    x0 = r[0]; u = r[2] * r[1];
}
HD void el_hyena_conv8(const float* u  , const float* x0, const float* kf  , const float* kb, const float* hbias, int m0, int c, float (&y)[8]) {
    const SeqInfo s = seq_of_row(m0); const int t0 = m0 - s.row0; const int base = (s.len == SEQ) ? 0 : SEQ;
    float acc[8];
#pragma unroll
    for (int i = 0; i < 8; ++i) acc[i] = 0.f;
    for (int s0 = 0; s0 < s.len; s0 += 8) {
        float uu[8], kk[15];
#pragma unroll
        for (int j = 0; j < 8; ++j) uu[j] = u[(size_t)(s.row0 + s0 + j) * HW + c];
#pragma unroll
        for (int e = 0; e < 15; ++e) { const int d = t0 - s0 - 7 + e; kk[e] = d >= 0 ? kf[(size_t)(base + d) * HW + c] : kb[(size_t)(base - d) * HW + c]; }
#pragma unroll
        for (int i = 0; i < 8; ++i)
#pragma unroll
            for (int j = 0; j < 8; ++j) acc[i] += uu[j] * kk[i - j + 7];
    }
#pragma unroll
    for (int i = 0; i < 8; ++i) y[i] = x0[(size_t)(m0 + i) * HW + c] * (acc[i] + hbias[c] * u[(size_t)(m0 + i) * HW + c]);
}

HD float el_lru_pre(const bf16* p, const float* cw  , const float* cb, int m, int c) {
    const SeqInfo s = seq_of_row(m); const int t = m - s.row0; float acc = cb[c];
    for (int j = 0; j < 4; ++j) { const int tt = t + j - 2; if (tt >= 0 && tt < s.len) acc += bf2f(p[(size_t)(s.row0 + tt) * IN_EVEN + 3 * HW + LW + c]) * cw[j * LW + c]; }
    return acc;
}
HD void el_lru_gate(const float* xb  , const float* wa  , const float* ba  , const float* wx, const float* bx, const float* lam, int m, int c, float& a, float& b) {
    const int n = c / LB, d = c % LB; float sa = ba[c], sx = bx[c];
    const float* xr = xb + (size_t)m * LW + n * LB;
    for (int cc = 0; cc < LB; ++cc) { const float xv = xr[cc]; sa += xv * wa[((size_t)n * LB + cc) * LB + d]; sx += xv * wx[((size_t)n * LB + cc) * LB + d]; }
    const float r = sigmoidf_(sa), i = sigmoidf_(sx);
    const float log_a = -8.0f * r * softplusf_(-lam[c]);
    a = expf(log_a); b = sqrtf(-expm1f(2.0f * log_a)) * (i * xb[(size_t)m * LW + c]);
}
HD void el_lru_scan(const float* __restrict__ a, const float* __restrict__ b  , float* __restrict__ h, int seq, int c, int reverse) {
    const int row0 = seq < BATCH ? seq * SEQ : BATCH * SEQ, len = seq < BATCH ? SEQ : DEC_SEQ; float s = 0.f;
    for (int tb = 0; tb < len; tb += 8) {
        float aa[8], bb[8];
#pragma unroll
        for (int k = 0; k < 8; ++k) { const int t = reverse ? len - 1 - (tb + k) : tb + k; const size_t i = (size_t)(row0 + t) * LW + c; aa[k] = a[i]; bb[k] = b[i]; }
#pragma unroll
        for (int k = 0; k < 8; ++k) { const int t = reverse ? len - 1 - (tb + k) : tb + k; const size_t i = (size_t)(row0 + t) * LW + c; s = aa[k] * s + bb[k]; h[i] = s; }
    }
}
HD float el_lru_out(const bf16* p, const float* hf, const float* hb, int m, int c) {
    return (hf[(size_t)m * LW + c] + hb[(size_t)m * LW + c]) * gelu_tanhf_(bf2f(p[(size_t)m * IN_EVEN + 3 * HW + c]));
}

HD void el_rope(bf16* qkv, int m, int which, int sh, int d, float qscale) {
    const SeqInfo s = seq_of_row(m); const int t = m - s.row0;
    const float inv = powf(10000.0f, -(float)(2 * d) / (float)DH), ang = (float)t * inv, cs = cosf(ang), sn = sinf(ang);
    bf16* x = qkv + (size_t)m * QKV_N + which * D_MODEL + sh * DH;
    const float lo = bf2f(x[d]), hi = bf2f(x[d + DH / 2]); const float sc = which == 0 ? qscale : 1.0f;
    x[d] = (bf16)f2bf((lo * cs - hi * sn) * sc); x[d + DH / 2] = (bf16)f2bf((hi * cs + lo * sn) * sc);
}
HD float attn_lambda_of(const float* lv  , int layer) { float s0 = 0.f, s1 = 0.f; for (int d = 0; d < DH; ++d) { s0 += lv[d] * lv[DH + d]; s1 += lv[2 * DH + d] * lv[3 * DH + d]; } return expf(s0) - expf(s1) + lambda_init_of(layer); }
HD void el_attn(const bf16* qkv, float* oc  , int m, int h, int comp, int row0, int len) {
    float q[DH], acc[DV];
    const bf16* qp = qkv + (size_t)m * QKV_N + (h * 2 + comp) * DH;
#pragma unroll
    for (int d = 0; d < DH; ++d) q[d] = bf2f(qp[d]);
#pragma unroll
    for (int e = 0; e < DV; ++e) acc[e] = 0.f;
    float mx = -INFINITY, l = 0.f;
    const bf16* kp = qkv + (size_t)row0 * QKV_N + D_MODEL + (h * 2 + comp) * DH;
    const bf16* vp = qkv + (size_t)row0 * QKV_N + 2 * D_MODEL + h * DV;
    for (int key = 0; key < len; ++key, kp += QKV_N, vp += QKV_N) {
        float sc = 0.f;
#pragma unroll
        for (int d = 0; d < DH; ++d) sc += q[d] * bf2f(kp[d]);
        if (sc > mx) { const float f = expf(mx - sc); l *= f;
#pragma unroll
            for (int e = 0; e < DV; ++e) acc[e] *= f;
            mx = sc; }
        const float pr = expf(sc - mx); l += pr;
#pragma unroll
        for (int e = 0; e < DV; ++e) acc[e] += pr * bf2f(vp[e]);
    }
    const float il = 1.0f / l; float* o = oc + (((size_t)comp * M + m) * ATT_HEADS + h) * DV;
#pragma unroll
    for (int e = 0; e < DV; ++e) o[e] = acc[e] * il;
}
HD void el_attn_fin(const float* oc, const float* subln  , float lam, float one_minus_li, bf16* y  , int m, int h) {
    const float* o0 = oc + (((size_t)0 * M + m) * ATT_HEADS + h) * DV; const float* o1 = oc + (((size_t)1 * M + m) * ATT_HEADS + h) * DV;
    float ss = 0.f;
    for (int e = 0; e < DV; ++e) { const float v = o0[e] - lam * o1[e]; ss += v * v; }
    const float rs = 1.0f / sqrtf(ss / (float)DV + NORM_EPS);
    for (int e = 0; e < DV; ++e) { const float v = o0[e] - lam * o1[e]; y[(size_t)m * D_MODEL + h * DV + e] = (bf16)f2bf(v * rs * subln[e] * one_minus_li); }
}
HD float silu_mul(float h1, float h3) { return h1 / (1.0f + expf(-h1)) * h3; }
HD void up_row_src(int n, int& which, int& col) { which = (n % 256) / 128; col = 128 * (n / 256) + (n % 128); }
HD int qkv_row_src(int n) { const int pn = n / 256; if (pn >= 2 * D_MODEL / 256) return n; const int bj = (n % 256) / 128, jj = n % 128; return (pn * 4 + jj / 32) * DH + bj * (DH / 2) + (jj % 32); }

#ifndef CPU_TEST
namespace pg8 {
#define PG8_LAS __attribute__((address_space(3)))
typedef unsigned short bf16_t;
typedef short bf16x8 __attribute__((ext_vector_type(8)));
typedef float f32x4 __attribute__((ext_vector_type(4)));
typedef unsigned u32x4 __attribute__((ext_vector_type(4)));
constexpr int BM = 256, BK = 64, HALF = 128, HTB = HALF * BK * 2  , STAGE_BYTES = 8 * HTB, NXCD = 8, WGM = 8;

__host__ __device__ __forceinline__ int lds_byte(int r, int c) { const int st = (r >> 4) * 2 + (c >> 5), rr = r & 15, cc = c & 31, ob = rr * 64 + cc * 2; return st * 1024 + (ob ^ (((ob >> 9) & 1) << 5)); }
__host__ __device__ __forceinline__ void stage_rc(int b, int& R, int& C) { const int st = b / 1024, sb = b % 1024, swz = sb ^ (((sb >> 9) & 1) << 5); R = (st >> 1) * 16 + swz / 64; C = (st & 1) * 32 + (swz % 64) / 2; }
__host__ __device__ __forceinline__ int perm32(int rho) { const int n = rho >> 4, i = rho & 15; return 8 * (i >> 2) + 4 * n + (i & 3); }

struct Unit { int pm, pn; };
struct Gemm { const bf16_t* A; const bf16_t* Bt; int M, N, K; };

struct StaticOrder {
    int nM, nN, nwg, G, c;
    __host__ __device__ void init(int M, int N, int G_, int c_) { nM = M / BM; nN = N / BM; nwg = nM * nN; G = G_; c = c_; }
    __host__ __device__ bool next(int i, Unit& u) const {
        const long L = (long)i * G + c; if (L >= nwg) return false;
        int wgid = (int)L; { const int q = nwg / NXCD, r = nwg % NXCD, xcd = wgid % NXCD, off = wgid / NXCD; wgid = (xcd < r ? xcd * (q + 1) : r * (q + 1) + (xcd - r) * q) + off; }
        const int nig = WGM * nN, gid = wgid / nig, fm = gid * WGM, gsz = (nM - fm) < WGM ? (nM - fm) : WGM;
        u.pm = fm + ((wgid % nig) % gsz); u.pn = (wgid % nig) / gsz; return true;
    }
    __device__ __forceinline__ void a_ready(const Unit&) const {}
    __device__ __forceinline__ void done(const Unit&) const {}
};
__device__ __forceinline__ unsigned cvt_pk_bf16(float lo, float hi) { unsigned r; asm volatile("v_cvt_pk_bf16_f32 %0, %1, %2" : "=v"(r) : "v"(lo), "v"(hi)); return r; }
typedef float f32x2 __attribute__((ext_vector_type(2)));
struct EpiBf16Plain {
    static constexpr bool PERM = true, AFTER_DRAIN = false;
    bf16_t* O; int ldc;
    __device__ __forceinline__ void operator()(const f32x4 (&acc)[2][2][4][2], const Unit& u, int wr, int wc, int fr, int fq) const {
        const int row0 = u.pm * BM + wr * 64 + fr, col0 = u.pn * BM + wc * 32 + 8 * fq;
#pragma unroll
        for (int ai = 0; ai < 2; ++ai)
#pragma unroll
            for (int m = 0; m < 4; ++m) { bf16_t* rowp = O + (size_t)(row0 + ai * HALF + m * 16) * ldc + col0;
#pragma unroll
                for (int bj = 0; bj < 2; ++bj) { const f32x4 v0 = acc[ai][bj][m][0], v1 = acc[ai][bj][m][1];
                    u32x4 w; w.x = cvt_pk_bf16(v0[0], v0[1]); w.y = cvt_pk_bf16(v0[2], v0[3]); w.z = cvt_pk_bf16(v1[0], v1[1]); w.w = cvt_pk_bf16(v1[2], v1[3]);
                    *(u32x4*)(rowp + bj * HALF) = w; } }
    }
};
__device__ __forceinline__ float silu_mul_fast(float h1, float h3) { return h1 * __builtin_amdgcn_rcpf(1.0f + __builtin_amdgcn_exp2f(-1.4426950408889634f * h1)) * h3; }
struct EpiSwiGLU {
    static constexpr bool PERM = true, AFTER_DRAIN = false;
    bf16_t* O; int ldc;
    __device__ __forceinline__ void operator()(const f32x4 (&acc)[2][2][4][2], const Unit& u, int wr, int wc, int fr, int fq) const {
        const int row0 = u.pm * BM + wr * 64 + fr, col0 = u.pn * HALF + wc * 32 + 8 * fq;
#pragma unroll
        for (int ai = 0; ai < 2; ++ai)
#pragma unroll
            for (int m = 0; m < 4; ++m) { bf16_t* rowp = O + (size_t)(row0 + ai * HALF + m * 16) * ldc + col0;
                float g[8];
#pragma unroll
                for (int n = 0; n < 2; ++n)
#pragma unroll
                    for (int j = 0; j < 4; ++j) g[4 * n + j] = silu_mul_fast(acc[ai][0][m][n][j], acc[ai][1][m][n][j]);
                u32x4 w; w.x = cvt_pk_bf16(g[0], g[1]); w.y = cvt_pk_bf16(g[2], g[3]); w.z = cvt_pk_bf16(g[4], g[5]); w.w = cvt_pk_bf16(g[6], g[7]);
                *(u32x4*)rowp = w; }
    }
};
struct EpiResid {
    static constexpr bool PERM = false, AFTER_DRAIN = false;
    float* X; int ldc; float scale;
    __device__ __forceinline__ void operator()(const f32x4 (&acc)[2][2][4][2], const Unit& u, int wr, int wc, int fr, int fq) const {
        const int row0 = u.pm * BM + wr * 64 + fr, col0 = u.pn * BM + wc * 32 + 4 * fq;
#pragma unroll
        for (int ai = 0; ai < 2; ++ai)
#pragma unroll
            for (int m = 0; m < 4; ++m) { float* rowp = X + (size_t)(row0 + ai * HALF + m * 16) * ldc + col0;
                f32x4 old[2][2];
#pragma unroll
                for (int bj = 0; bj < 2; ++bj)
#pragma unroll
                    for (int n = 0; n < 2; ++n) old[bj][n] = *(const f32x4*)(rowp + bj * HALF + n * 16);
#pragma unroll
                for (int bj = 0; bj < 2; ++bj)
#pragma unroll
                    for (int n = 0; n < 2; ++n) *(f32x4*)(rowp + bj * HALF + n * 16) = old[bj][n] + acc[ai][bj][m][n] * scale; }
    }
};
template <class Epi, class Sched, bool ALIGN_EPI = false, bool SP2 = false, bool ABLK = false, bool BBLK = false>
__device__ __forceinline__ void gemm_phase(PG8_LAS unsigned char* lds, const Gemm g, const Sched& S, const Epi& E, int tid_in) {
    int tid_ = tid_in; asm volatile("" : "+v"(tid_));
    const int tid = tid_, wid = __builtin_amdgcn_readfirstlane(tid >> 6), lane = tid & 63, wr = wid >> 2, wc = wid & 3, fr = lane & 15, fq = lane >> 4;
    const int K = g.K, nt = K / BK;
    unsigned voffA[2], voffB[2];
#pragma unroll
    for (int i = 0; i < 2; ++i) { int R, C; stage_rc(tid * 16 + i * 8192, R, C); const int Rb = Epi::PERM ? ((R & ~31) + perm32(R & 31)) : R;
        voffA[i] = (unsigned)(R * (ABLK ? BK : K) + C) * 2u; voffB[i] = (unsigned)(Rb * (BBLK ? BK : K) + C) * 2u; }
    const size_t kstepA = ABLK ? (size_t)BM * BK * 2 : (size_t)(BK * 2), kstepB = BBLK ? (size_t)BM * BK * 2 : (size_t)(BK * 2);
    const size_t hstepA = ABLK ? (size_t)HALF * BK * 2 : (size_t)HALF * K * 2, hstepB = BBLK ? (size_t)HALF * BK * 2 : (size_t)HALF * K * 2;
    const size_t tstep = (size_t)BM * K * 2;
    const unsigned ldsw = (unsigned)wid * 1024u;
    const int aoff = lds_byte(wr * 64 + fr, fq * 8), boff = lds_byte(wc * 32 + fr, fq * 8);
#define PG8_SA(b, h) (((b) * 2 + (h)) * HTB)
#define PG8_SB(b, h) ((4 + (b) * 2 + (h)) * HTB)
#define PG8_STAGE(bufoff, gbase, voff) do { _Pragma("unroll") for (int _i = 0; _i < 2; ++_i) \
        __builtin_amdgcn_global_load_lds((const unsigned*)((const char*)(gbase) + (voff)[_i]), (PG8_LAS unsigned*)(lds + (bufoff) + ldsw + _i * 8192), 16, 0, 0); } while (0)
#define PG8_LDA(dst, b, h) do { _Pragma("unroll") for (int m = 0; m < 4; ++m) _Pragma("unroll") for (int k = 0; k < 2; ++k) dst[m][k] = *(const PG8_LAS bf16x8*)(lds + PG8_SA(b, h) + aoff + m * 2048 + k * 1024); } while (0)
#define PG8_LDB(dst, b, h) do { _Pragma("unroll") for (int n = 0; n < 2; ++n) _Pragma("unroll") for (int k = 0; k < 2; ++k) dst[n][k] = *(const PG8_LAS bf16x8*)(lds + PG8_SB(b, h) + boff + n * 2048 + k * 1024); } while (0)
#define PG8_MMA(ai, bj, At, Bt) do { __builtin_amdgcn_s_setprio(1); _Pragma("unroll") for (int m = 0; m < 4; ++m) _Pragma("unroll") for (int n = 0; n < 2; ++n) _Pragma("unroll") for (int k = 0; k < 2; ++k) \
        acc[ai][bj][m][n] = __builtin_amdgcn_mfma_f32_16x16x32_bf16(Bt[n][k], At[m][k], acc[ai][bj][m][n], 0, 0, 0); __builtin_amdgcn_s_setprio(0); } while (0)
#define PG8_WAIT_V(n) asm volatile("s_waitcnt vmcnt(" #n ")" ::: "memory")
#define PG8_WAIT_L(n) asm volatile("s_waitcnt lgkmcnt(" #n ")" ::: "memory")
#define PG8_BAR __builtin_amdgcn_s_barrier()
#define PG8_SCHED __builtin_amdgcn_sched_barrier(0)
    Unit cur, nxt; int ui = 0;
    if (!S.next(0, cur)) return;
    f32x4 acc[2][2][4][2];
#pragma unroll
    for (int a = 0; a < 2; ++a)
#pragma unroll
        for (int b = 0; b < 2; ++b)
#pragma unroll
            for (int m = 0; m < 4; ++m)
#pragma unroll
                for (int n = 0; n < 2; ++n) acc[a][b][m][n] = (f32x4){0.f, 0.f, 0.f, 0.f};
    bf16x8 At[4][2], B0[2][2], B1[2][2];
    const char* cA = (const char*)g.A + (size_t)cur.pm * tstep; const char* cB = (const char*)g.Bt + (size_t)cur.pn * tstep;
    S.a_ready(cur);
    if constexpr (SP2) {
        PG8_STAGE(PG8_SB(0, 0), cB, voffB); PG8_STAGE(PG8_SB(0, 1), cB + hstepB, voffB); PG8_STAGE(PG8_SA(0, 0), cA, voffA); PG8_STAGE(PG8_SA(0, 1), cA + hstepA, voffA);
        if (wr == 1) PG8_BAR;
        PG8_WAIT_V(2); PG8_BAR;
        PG8_STAGE(PG8_SB(1, 0), cB + kstepB, voffB); PG8_STAGE(PG8_SA(1, 0), cA + kstepA, voffA); PG8_STAGE(PG8_SB(1, 1), cB + hstepB + kstepB, voffB);
        PG8_WAIT_V(6); PG8_BAR;
    } else {
        PG8_STAGE(PG8_SB(0, 0), cB, voffB); PG8_STAGE(PG8_SA(0, 0), cA, voffA); PG8_STAGE(PG8_SB(0, 1), cB + hstepB, voffB); PG8_STAGE(PG8_SA(0, 1), cA + hstepA, voffA);
        if (wr == 1) PG8_BAR;
        PG8_WAIT_V(4); PG8_BAR;
        PG8_STAGE(PG8_SB(1, 0), cB + kstepB, voffB); PG8_STAGE(PG8_SA(1, 0), cA + kstepA, voffA); PG8_STAGE(PG8_SB(1, 1), cB + hstepB + kstepB, voffB);
        PG8_WAIT_V(6); PG8_BAR;
    }
    for (;;) {
        const bool has_next = S.next(ui + 1, nxt);
        const char* nA = has_next ? (const char*)g.A + (size_t)nxt.pm * tstep : cA; const char* nB = has_next ? (const char*)g.Bt + (size_t)nxt.pn * tstep : cB;
        for (int t = 0; t < nt; t += 2) {
            const bool last = (t == nt - 2);
            const char* a1 = cA + (size_t)(t + 1) * kstepA;
            const char* a2 = last ? nA : cA + (size_t)(t + 2) * kstepA; const char* b2 = last ? nB : cB + (size_t)(t + 2) * kstepB;
            const char* a3 = a2 + kstepA; const char* b3 = b2 + kstepB;
            if (last && has_next) S.a_ready(nxt);
            if constexpr (SP2) {
            PG8_LDB(B0, 0, 0); PG8_LDB(B1, 0, 1); PG8_SCHED; PG8_LDA(At, 0, 0); PG8_STAGE(PG8_SA(1, 1), a1 + hstepA, voffA);
            PG8_WAIT_V(8); PG8_WAIT_L(0); PG8_BAR; PG8_MMA(0, 0, At, B0); PG8_MMA(0, 1, At, B1); PG8_BAR; PG8_SCHED;
            PG8_LDA(At, 0, 1); PG8_STAGE(PG8_SB(0, 0), b2, voffB); PG8_STAGE(PG8_SB(0, 1), b2 + hstepB, voffB); PG8_STAGE(PG8_SA(0, 0), a2, voffA);
            PG8_WAIT_V(8); PG8_WAIT_L(0); PG8_BAR; PG8_MMA(1, 0, At, B0); PG8_MMA(1, 1, At, B1); PG8_BAR; PG8_SCHED;
            PG8_LDB(B0, 1, 0); PG8_LDB(B1, 1, 1); PG8_SCHED; PG8_LDA(At, 1, 0); PG8_STAGE(PG8_SA(0, 1), a2 + hstepA, voffA);
            PG8_WAIT_V(8); PG8_WAIT_L(0); PG8_BAR; PG8_MMA(0, 0, At, B0); PG8_MMA(0, 1, At, B1); PG8_BAR; PG8_SCHED;
            PG8_LDA(At, 1, 1); PG8_STAGE(PG8_SB(1, 0), b3, voffB); PG8_STAGE(PG8_SB(1, 1), b3 + hstepB, voffB); PG8_STAGE(PG8_SA(1, 0), a3, voffA);
            PG8_WAIT_V(8); PG8_WAIT_L(0); PG8_BAR; PG8_MMA(1, 0, At, B0); PG8_MMA(1, 1, At, B1); PG8_BAR; PG8_SCHED;
            } else {
            PG8_LDB(B0, 0, 0); PG8_SCHED; PG8_LDA(At, 0, 0); PG8_STAGE(PG8_SA(1, 1), a1 + hstepA, voffA);
            PG8_WAIT_L(8); PG8_BAR; PG8_WAIT_L(0); PG8_MMA(0, 0, At, B0); PG8_BAR; PG8_SCHED;
            PG8_LDB(B1, 0, 1); PG8_STAGE(PG8_SB(0, 0), b2, voffB);
            PG8_BAR; PG8_WAIT_L(0); PG8_MMA(0, 1, At, B1); PG8_BAR;
            PG8_LDA(At, 0, 1); PG8_STAGE(PG8_SA(0, 0), a2, voffA);
            PG8_BAR; PG8_WAIT_L(0); PG8_MMA(1, 0, At, B0); PG8_BAR; PG8_SCHED;
            PG8_STAGE(PG8_SB(0, 1), b2 + hstepB, voffB);
            PG8_WAIT_V(6); PG8_BAR; PG8_MMA(1, 1, At, B1); PG8_BAR;
            PG8_LDB(B0, 1, 0); PG8_SCHED; PG8_LDA(At, 1, 0); PG8_STAGE(PG8_SA(0, 1), a2 + hstepA, voffA);
            PG8_WAIT_L(8); PG8_BAR; PG8_WAIT_L(0); PG8_MMA(0, 0, At, B0); PG8_BAR; PG8_SCHED;
            PG8_LDB(B1, 1, 1); PG8_STAGE(PG8_SB(1, 0), b3, voffB);
            PG8_BAR; PG8_WAIT_L(0); PG8_MMA(0, 1, At, B1); PG8_BAR;
            PG8_LDA(At, 1, 1); PG8_STAGE(PG8_SA(1, 0), a3, voffA);
            PG8_BAR; PG8_WAIT_L(0); PG8_MMA(1, 0, At, B0); PG8_BAR; PG8_SCHED;
            PG8_STAGE(PG8_SB(1, 1), b3 + hstepB, voffB);
            PG8_WAIT_V(6); PG8_BAR; PG8_MMA(1, 1, At, B1); PG8_BAR;
            }
        }
        if constexpr (ALIGN_EPI) { if (wr == 0) PG8_BAR; }
        if constexpr (!Epi::AFTER_DRAIN) { E(acc, cur, wr, wc, fr, fq); S.done(cur); }
        if (!has_next) break;
#pragma unroll
        for (int a = 0; a < 2; ++a)
#pragma unroll
            for (int b = 0; b < 2; ++b)
#pragma unroll
                for (int m = 0; m < 4; ++m)
#pragma unroll
                    for (int n = 0; n < 2; ++n) acc[a][b][m][n] = (f32x4){0.f, 0.f, 0.f, 0.f};
        cur = nxt; cA = nA; cB = nB; ++ui;
        if constexpr (ALIGN_EPI) { if (wr == 1) PG8_BAR; }
    }
    PG8_WAIT_V(0);
    if constexpr (!ALIGN_EPI) { if (wr == 0) PG8_BAR; }
    PG8_BAR;
    if constexpr (Epi::AFTER_DRAIN) { E.fused(acc, cur, wr, wc, fr, fq, lds, wid, lane); S.done(cur); }
#undef PG8_SA
#undef PG8_SB
#undef PG8_STAGE
#undef PG8_LDA
#undef PG8_LDB
#undef PG8_MMA
#undef PG8_WAIT_V
#undef PG8_WAIT_L
#undef PG8_BAR
#undef PG8_SCHED
}
}

#define GAS __attribute__((address_space(1)))
#define LAS __attribute__((address_space(3)))
typedef unsigned v4u __attribute__((ext_vector_type(4)));
typedef float f32x4 __attribute__((ext_vector_type(4)));
typedef GAS unsigned gu32;
#define RLX_AGENT __ATOMIC_RELAXED, __HIP_MEMORY_SCOPE_AGENT
#define LDS_WAIT() asm volatile("s_waitcnt lgkmcnt(0)" ::: "memory")
#define VM_WAIT() asm volatile("s_waitcnt vmcnt(0)" ::: "memory")
__device__ __forceinline__ unsigned pk2(float lo, float hi) { return f2bf(lo) | (f2bf(hi) << 16); }

#define XB_TMO      128
#define XB_XCNT(j)  (256  + 64 * (j))
#define XB_XSUB(j)  (1280 + 64 * (j))
#define XB_XGEN(j)  (2304 + 64 * (j))
#define XB_TOP      3328
#define XB_TOPGEN   3392
#define XCD_BAR_WORDS 3456
#define XB_SPIN_CAP (1u << 18)

__device__ __forceinline__ unsigned xb_ld(unsigned* p)              { return __hip_atomic_load(p, __ATOMIC_RELAXED, __HIP_MEMORY_SCOPE_AGENT); }
__device__ __forceinline__ unsigned xb_add(unsigned* p, unsigned v) { return __hip_atomic_fetch_add(p, v, __ATOMIC_RELAXED, __HIP_MEMORY_SCOPE_AGENT); }
__device__ __forceinline__ unsigned xb_xcc_id() { return (unsigned)__builtin_amdgcn_s_getreg((3 << 11) | 20) & 0xFu; }
#define XB_SPIN(cond, bar) do { unsigned _sp = 0; while (cond) { __builtin_amdgcn_s_sleep(1); \
    if ((++_sp & 255u) == 0u) { if (xb_ld(&(bar)[XB_TMO])) break; if (_sp > XB_SPIN_CAP) { atomicAdd(&(bar)[XB_TMO], 1u); break; } } } } while (0)

struct XcdBarrier {
    unsigned* bar; unsigned x;
    volatile LAS unsigned* st;
};

__device__ __forceinline__ XcdBarrier xcd_barrier_post(unsigned* bar, volatile LAS unsigned* st) {
    XcdBarrier b; b.bar = bar; b.x = xb_xcc_id(); b.st = st;
    if (threadIdx.x == 0) (void)xb_add(&bar[XB_XCNT(b.x)], 1u);
    return b;
}
__device__ __forceinline__ void xcd_barrier_complete(unsigned* bar, unsigned x, unsigned& nloc, unsigned& nx) {
    const unsigned G = gridDim.x * gridDim.y * gridDim.z;
    unsigned sum, cnt, mine, sp = 0u;
    for (;;) {
        sum = 0u; cnt = 0u; mine = 0u;
#pragma unroll
        for (unsigned j = 0; j < 16; ++j) { const unsigned c = xb_ld(&bar[XB_XCNT(j)]); sum += c; cnt += (c > 0u) ? 1u : 0u; mine = (j == x) ? c : mine; }
        if (sum == G) break;
        __builtin_amdgcn_s_sleep(1);
        if ((++sp & 255u) == 0u) { if (xb_ld(&bar[XB_TMO])) break; if (sp > XB_SPIN_CAP) { atomicAdd(&bar[XB_TMO], 1u); break; } }
    }
    nloc = mine > 0u ? mine : 1u; nx = cnt > 0u ? cnt : 1u;
}

__device__ __forceinline__ void xcd_barrier(const XcdBarrier& b) {
    asm volatile("s_waitcnt vmcnt(0)" ::: "memory");
    __syncthreads();
    if (threadIdx.x == 0) {
        unsigned* bar = b.bar;
        __builtin_amdgcn_s_waitcnt(0);
        unsigned nloc = b.st[0], nx = b.st[1];
        if (nloc == 0u) { xcd_barrier_complete(bar, b.x, nloc, nx); b.st[0] = nloc; b.st[1] = nx; }
        const unsigned old = xb_add(&bar[XB_XSUB(b.x)], 1u);
        const unsigned gen = old / nloc;
        if (old + 1u == (gen + 1u) * nloc) {
            __builtin_amdgcn_fence(__ATOMIC_RELEASE, "agent");
            asm volatile("s_waitcnt vmcnt(0)" ::: "memory");
            const unsigned og = xb_add(&bar[XB_TOP], 1u);
            const unsigned tg = og / nx;
            if (og + 1u == (tg + 1u) * nx) xb_add(&bar[XB_TOPGEN], 1u);
            else XB_SPIN(xb_ld(&bar[XB_TOPGEN]) == tg, bar);
            __builtin_amdgcn_fence(__ATOMIC_ACQUIRE, "agent");
            xb_add(&bar[XB_XGEN(b.x)], 1u);
            asm volatile("s_waitcnt vmcnt(0)" ::: "memory");
        } else {
            XB_SPIN(xb_ld(&bar[XB_XGEN(b.x)]) == gen, bar);
            __builtin_amdgcn_fence(__ATOMIC_ACQUIRE, "agent");
            asm volatile("s_waitcnt vmcnt(0)" ::: "memory");
        }
    }
    __syncthreads();
}

constexpr int NWAVES = 8, NTHREADS = NWAVES * 64;
constexpr size_t MiB = 1u << 20;
constexpr size_t WS_CTL = 0, CTL_ZERO_BYTES = 1 * MiB;
constexpr size_t UP_BYTES = (size_t)UP_N * D_MODEL * 2, DN_BYTES = (size_t)D_MODEL * D_FF * 2, EIN_BYTES = (size_t)IN_EVEN * D_MODEL * 2, SQ_BYTES = (size_t)D_MODEL * D_MODEL * 2, QKVW_BYTES = (size_t)QKV_N * D_MODEL * 2;
constexpr size_t WS_WUP = 4 * MiB, WS_WDN = WS_WUP + 8 * UP_BYTES, WS_WEIN = WS_WDN + 8 * DN_BYTES, WS_WEOUT = WS_WEIN + 2 * EIN_BYTES, WS_WQKV = WS_WEOUT + 2 * SQ_BYTES, WS_WWO = WS_WQKV + 2 * QKVW_BYTES;
constexpr size_t WS_H = WS_WWO + 2 * SQ_BYTES;
constexpr size_t WS_G = WS_H + (size_t)M * D_MODEL * 2;
constexpr size_t WS_Y = WS_G + (size_t)M * QKV_N * 2;
constexpr size_t WS_S = WS_Y + (size_t)M * D_MODEL * 2;
constexpr size_t SLAB = (size_t)M * 1024 * 4;
constexpr size_t WS_XB = WS_S, WS_A = WS_S + SLAB, WS_B = WS_S + 2 * SLAB, WS_HF = WS_S + 3 * SLAB, WS_HB = WS_S + 4 * SLAB;
constexpr size_t WS_U = WS_HF, WS_X0 = WS_HB;
constexpr size_t WS_OC = WS_S;
constexpr size_t WS_KF = WS_S + 5 * SLAB, WS_KB = WS_KF + (size_t)FILT_T * HW * 4;
constexpr size_t WS_UT = WS_HF, WS_X0T = WS_HB;
constexpr size_t WS_YT = WS_KF;
constexpr size_t F8_BYTES = (size_t)HW * 2 * DEC_SEQ * 2, F4_BYTES = (size_t)HW * 2 * SEQ * 2;
__host__ __device__ constexpr size_t ws_filt(int j) { return j == 0 ? WS_KB : WS_A; }
static_assert(N_EVEN == 2 && F8_BYTES + F4_BYTES <= (size_t)FILT_T * HW * 4 && F8_BYTES + F4_BYTES <= SLAB, "filter regions");
static_assert((size_t)HW * M * 2 <= SLAB && (size_t)HW * M * 2 <= (size_t)FILT_T * HW * 4 && (size_t)HW * 2 * (DEC_SEQ + SEQ) * 2 <= (size_t)FILT_T * HW * 4, "hyena staging fits the old f32 filter regions");
constexpr size_t WS_FH = WS_KB + (size_t)FILT_T * HW * 4;
constexpr size_t WS_LWT = WS_FH + (size_t)3 * N_EVEN * FILT_T * FO * 4;
constexpr size_t LWT_LAYER = (size_t)2 * 2 * LRU_BLOCKS * LB * LB;
constexpr int N_NORM = 3 * DEPTH + 1;
constexpr size_t WS_ROPE = WS_LWT + N_EVEN * LWT_LAYER * 2;
constexpr size_t WS_ROWSS = CTL_ZERO_BYTES;
constexpr size_t ROWSS_BYTES = (size_t)N_NORM * M * 8;
constexpr size_t WS_KMAX = WS_ROWSS + ROWSS_BYTES;
constexpr size_t KMAX_LAYER = 3 * 2 * ATT_HEADS, KMAX_BYTES = 1024;
static_assert(N_ODD * KMAX_LAYER * 4 <= KMAX_BYTES && BATCH == 2, "kmax region");
constexpr size_t ZERO_BYTES = WS_KMAX + KMAX_BYTES;
constexpr size_t WS_NSP = WS_WUP - 64 * 1024;
static_assert(ZERO_BYTES <= WS_NSP, "zeroed region ends before the weight copies");
constexpr size_t WS_END = WS_ROPE + (size_t)DEC_SEQ * (DH / 2) * 2 * 4;
constexpr size_t WS_AGG = WS_XB, WS_CARRY = WS_XB + 8 * MiB;
constexpr int CW_BAR = 4096;

constexpr int RING_OFF = 0, RING_BYTES = 131072;
constexpr int LDSCTL_OFF = RING_BYTES, MISC_OFF = LDSCTL_OFF + 320;
constexpr int LDS_BYTES = 147456;
static_assert(MISC_OFF + 128 <= LDS_BYTES, "LDS map");

constexpr int PH_PRO0 = 0, PH_PRO1 = 1, PH_PRO2 = 2, PH_PRO3 = 3, PH_LAYER0 = 4, PH_PER_LAYER = 15, PH_FINAL = PH_LAYER0 + DEPTH * PH_PER_LAYER, NPHASES = PH_FINAL + 1;
__host__ __device__ inline bool phase_exists(int k) { if (k < PH_LAYER0 || k == PH_FINAL) return k >= 0; if (k > PH_FINAL) return false; const int l = (k - PH_LAYER0) / PH_PER_LAYER, s = (k - PH_LAYER0) % PH_PER_LAYER; return !(s == 0 || s == 3 || s == 12) && !(s >= 8 && s <= 10) && !((l & 1) && (s == 5 || s == 7)); }

struct Args { const float* in[29]; float* out; unsigned char* ws; int ph_lo, ph_hi; };

struct Frame {
    LAS unsigned char* lds;
    int tid, lane, wave, G, gtid, gsize, gw, ngw, bid;
};
__device__ __forceinline__ Frame make_frame(LAS unsigned char* lds, int wave_sgpr) {
    unsigned z = 0u; asm volatile("" : "+v"(z));
    const int lane = (int)__builtin_amdgcn_mbcnt_hi(~0u, __builtin_amdgcn_mbcnt_lo(~0u, z));
    const int t = wave_sgpr * 64 + lane;
    Frame F; F.lds = lds; F.tid = t; F.lane = lane; F.wave = wave_sgpr;
    int b = blockIdx.x; asm volatile("" : "+s"(b));
    F.bid = b; F.G = gridDim.x; F.gtid = b * NTHREADS + t; F.gsize = F.G * NTHREADS; F.gw = b * NWAVES + F.wave; F.ngw = F.G * NWAVES;
    return F;
}
typedef const Args __attribute__((address_space(4))) CArgs;
__device__ __forceinline__ const CArgs* opaque_args() { const CArgs* a = (const CArgs*)__builtin_amdgcn_kernarg_segment_ptr(); asm volatile("" : "+s"(a)); return a; }
__device__ __forceinline__ float wave_sum(float v, int lane) {
#pragma unroll
    for (int o = 1; o < 64; o <<= 1) v += __builtin_bit_cast(float, __builtin_amdgcn_ds_bpermute((lane ^ o) << 2, __builtin_bit_cast(int, v)));
    return v;
}
__device__ __forceinline__ void transpose_tile(const float* W, int ldn, int K, int k0, int n0, bf16* WT, int drow0, LAS float* scr, int lane, const float* gain) {
    float tv[32];
    const float* wp = W + (size_t)(k0 + (lane >> 5)) * ldn + n0 + (lane & 31);
#pragma unroll
    for (int i = 0; i < 32; ++i) tv[i] = wp[(size_t)(2 * i) * ldn];
#pragma unroll
    for (int i = 0; i < 32; ++i) scr[(2 * i + (lane >> 5)) * 33 + (lane & 31)] = tv[i];
    LDS_WAIT(); asm volatile("" ::: "memory");
    const int c = lane & 7;
    float gk[8];
#pragma unroll
    for (int e = 0; e < 8; ++e) gk[e] = gain ? gain[k0 + 8 * c + e] : 1.0f;
#pragma unroll
    for (int j = 0; j < 4; ++j) { const int n = (lane >> 3) + 8 * j; const LAS float* s = scr + (8 * c) * 33 + n;
        v4u o; o.x = pk2(s[0 * 33] * gk[0], s[1 * 33] * gk[1]); o.y = pk2(s[2 * 33] * gk[2], s[3 * 33] * gk[3]); o.z = pk2(s[4 * 33] * gk[4], s[5 * 33] * gk[5]); o.w = pk2(s[6 * 33] * gk[6], s[7 * 33] * gk[7]);
        *(v4u*)(WT + (size_t)(drow0 + n) * K + k0 + 8 * c) = o; }
    LDS_WAIT(); asm volatile("" ::: "memory");
}
__device__ __forceinline__ void rms_row_to_bf16(const float* xrow, const float* g, bf16* orow, int lane) {
    const f32x4* xr = (const f32x4*)xrow + lane; const f32x4* gr = (const f32x4*)g + lane;
    f32x4 v[8]; float s = 0.f;
#pragma unroll
    for (int j = 0; j < 8; ++j) { v[j] = xr[64 * j]; s += (v[j].x * v[j].x + v[j].y * v[j].y) + (v[j].z * v[j].z + v[j].w * v[j].w); }
    const float rstd = 1.f / sqrtf(wave_sum(s, lane) * (1.f / D_MODEL) + NORM_EPS);
    unsigned long long* o8 = (unsigned long long*)orow + lane;
#pragma unroll
    for (int j = 0; j < 8; ++j) { const f32x4 gg = gr[64 * j];
        o8[64 * j] = (unsigned long long)pk2(v[j].x * rstd * gg.x, v[j].y * rstd * gg.y) | ((unsigned long long)pk2(v[j].z * rstd * gg.z, v[j].w * rstd * gg.w) << 32); }
}
__device__ __forceinline__ void rms_row_inplace_f32(float* xrow, const float* g, int lane) {
    f32x4* xr = (f32x4*)xrow + lane; const f32x4* gr = (const f32x4*)g + lane;
    f32x4 v[8]; float s = 0.f;
#pragma unroll
    for (int j = 0; j < 8; ++j) { v[j] = xr[64 * j]; s += (v[j].x * v[j].x + v[j].y * v[j].y) + (v[j].z * v[j].z + v[j].w * v[j].w); }
    const float rstd = 1.f / sqrtf(wave_sum(s, lane) * (1.f / D_MODEL) + NORM_EPS);
#pragma unroll
    for (int j = 0; j < 8; ++j) { const f32x4 gg = gr[64 * j]; xr[64 * j] = (f32x4){v[j].x * rstd * gg.x, v[j].y * rstd * gg.y, v[j].z * rstd * gg.z, v[j].w * rstd * gg.w}; }
}
static_assert(D_MODEL == 2048, "row helpers assume 2048-wide rows");

__device__ __forceinline__ void phase_prologue0(const Frame& F, const CArgs& a) {
    LAS float* scr = (LAS float*)(F.lds + RING_OFF + F.wave * 16384);
    unsigned char* ws = a.ws;
    constexpr int KT = D_MODEL / 64;
    constexpr int I_UP = KT * (UP_N / 32), I_DN = (D_FF / 64) * (D_MODEL / 32), I_EIN = KT * (IN_EVEN / 32), I_SQ = KT * (D_MODEL / 32), I_QKV = KT * (QKV_N / 32);
    constexpr int T_UP = 8 * I_UP, T_DN = 8 * I_DN, T_EIN = 2 * I_EIN, T_SQ = 2 * I_SQ, T_QKV = 2 * I_QKV;
    constexpr int NITEMS = T_UP + T_DN + T_EIN + T_SQ + T_QKV + T_SQ;
    for (int it = F.gw; it < NITEMS; it += F.ngw) {
        int r = it;
        if (r < T_UP) { const int mi = r / I_UP, q = r % I_UP, nblk = UP_N / 32, kb = q / nblk, nb = q % nblk, dn0 = 32 * nb;
            int which, col; up_row_src(dn0, which, col);
            const float* W = (which ? a.in[4] : a.in[3]) + (size_t)mi * D_MODEL * D_FF;
            transpose_tile(W, D_FF, D_MODEL, 64 * kb, col, (bf16*)(ws + WS_WUP + (size_t)mi * UP_BYTES), dn0, scr, F.lane, a.in[2] + (size_t)mi * D_MODEL); continue; }
        r -= T_UP;
        if (r < T_DN) { const int mi = r / I_DN, q = r % I_DN, nblk = D_MODEL / 32, kb = q / nblk, nb = q % nblk;
            transpose_tile(a.in[5] + (size_t)mi * D_FF * D_MODEL, D_MODEL, D_FF, 64 * kb, 32 * nb, (bf16*)(ws + WS_WDN + (size_t)mi * DN_BYTES), 32 * nb, scr, F.lane, nullptr); continue; }
        r -= T_DN;
        if (r < T_EIN) { const int mi = r / I_EIN, q = r % I_EIN, nblk = IN_EVEN / 32, kb = q / nblk, nb = q % nblk;
            transpose_tile(a.in[8] + (size_t)mi * D_MODEL * IN_EVEN, IN_EVEN, D_MODEL, 64 * kb, 32 * nb, (bf16*)(ws + WS_WEIN + (size_t)mi * EIN_BYTES), 32 * nb, scr, F.lane, a.in[6] + (size_t)(2 * mi) * D_MODEL); continue; }
        r -= T_EIN;
        if (r < T_SQ) { const int mi = r / I_SQ, q = r % I_SQ, nblk = D_MODEL / 32, kb = q / nblk, nb = q % nblk;
            transpose_tile(a.in[24] + (size_t)mi * D_MODEL * D_MODEL, D_MODEL, D_MODEL, 64 * kb, 32 * nb, (bf16*)(ws + WS_WEOUT + (size_t)mi * SQ_BYTES), 32 * nb, scr, F.lane, nullptr); continue; }
        r -= T_SQ;
        if (r < T_QKV) { const int mi = r / I_QKV, q = r % I_QKV, nblk = QKV_N / 32, kb = q / nblk, nb = q % nblk;
            transpose_tile(a.in[25] + (size_t)mi * D_MODEL * QKV_N, QKV_N, D_MODEL, 64 * kb, qkv_row_src(32 * nb), (bf16*)(ws + WS_WQKV + (size_t)mi * QKVW_BYTES), 32 * nb, scr, F.lane, a.in[6] + (size_t)(2 * mi + 1) * D_MODEL); continue; }
        r -= T_QKV;
        { const int mi = r / I_SQ, q = r % I_SQ, nblk = D_MODEL / 32, kb = q / nblk, nb = q % nblk;
            transpose_tile(a.in[28] + (size_t)mi * D_MODEL * D_MODEL, D_MODEL, D_MODEL, 64 * kb, 32 * nb, (bf16*)(ws + WS_WWO + (size_t)mi * SQ_BYTES), 32 * nb, scr, F.lane, nullptr); }
    }
    for (int i = F.gtid; i < N_EVEN * 2 * LW; i += F.gsize) ((float*)(ws + WS_NSP))[i] = -8.0f * softplusf_(-a.in[23][i]);
    { bf16* xb = (bf16*)(ws + WS_H); unsigned long long* rs0 = (unsigned long long*)(ws + WS_ROWSS);
      for (int m = F.gw; m < M; m += F.ngw) { const float* src = m < BATCH * SEQ ? a.in[0] + (size_t)m * D_MODEL : a.in[1] + (size_t)(m - BATCH * SEQ) * D_MODEL;
          const f32x4* xr = (const f32x4*)src + F.lane; f32x4* o = (f32x4*)(a.out + (size_t)m * D_MODEL) + F.lane; unsigned long long* o8 = (unsigned long long*)(xb + (size_t)m * D_MODEL) + F.lane; float s = 0.f;
          f32x4 vv[8];
#pragma unroll
          for (int j = 0; j < 8; ++j) vv[j] = xr[64 * j];
#pragma unroll
          for (int j = 0; j < 8; ++j) { const f32x4 v = vv[j]; o[64 * j] = v; s += (v.x * v.x + v.y * v.y) + (v.z * v.z + v.w * v.w); o8[64 * j] = (unsigned long long)pk2(v.x, v.y) | ((unsigned long long)pk2(v.z, v.w) << 32); }
          s = wave_sum(s, F.lane); if (F.lane == 0) rs0[m] = (unsigned long long)(s * 16777216.0f); } }
    { float* tab = (float*)(ws + WS_ROPE);
      for (int i = F.gtid; i < DEC_SEQ * (DH / 2); i += F.gsize) { const int d = i % (DH / 2), t = i / (DH / 2); const float inv = powf(10000.0f, -(float)(2 * d) / (float)DH), ang = (float)t * inv; tab[2 * i] = cosf(ang); tab[2 * i + 1] = sinf(ang); } }
    { bf16* lwt = (bf16*)(ws + WS_LWT);
      for (int i = F.gtid; i < (int)(N_EVEN * LWT_LAYER); i += F.gsize) { const int cc = i % LB, d = (i / LB) % LB, n = (i / (LB * LB)) % LRU_BLOCKS, ty = (i / (LB * LB * LRU_BLOCKS)) % 2, dir = (i / (LB * LB * LRU_BLOCKS * 2)) % 2, j = i / (LB * LB * LRU_BLOCKS * 4);
          lwt[i] = (bf16)f2bf((ty ? a.in[21] : a.in[19])[((((size_t)j * 2 + dir) * LRU_BLOCKS + n) * LB + cc) * LB + d]); } }
    { float* fh = (float*)(ws + WS_FH);
      for (int i = F.gtid; i < N_EVEN * FILT_T * FO; i += F.gsize) { const int q = i % FO, tt = (i / FO) % FILT_T, j = i / (FO * FILT_T);
          fh[i] = el_filt_h0(a.in[11] + j * EMB * FO, a.in[12] + j * 3 * FO, a.in[14] + j * FO, tt, q); } }
}
__device__ __forceinline__ void phase_filter_hidden(const Frame& F, const CArgs& a, int layer) {
    const float* src = (const float*)(a.ws + WS_FH) + (size_t)layer * N_EVEN * FILT_T * FO; float* dst = (float*)(a.ws + WS_FH) + (size_t)(layer + 1) * N_EVEN * FILT_T * FO;
    for (int i = F.gtid; i < N_EVEN * FILT_T * FO; i += F.gsize) { const int q = i % FO, j = i / (FO * FILT_T);
        dst[i] = el_filt_hid(src + (size_t)(i / FO) * FO, a.in[13] + (size_t)(j * 2 + layer) * FO * FO, a.in[12] + j * 3 * FO + (layer + 1) * FO, a.in[14] + j * FO, q); }
}
__device__ __forceinline__ void phase_norm(const Frame& F, const float* x, const float* g, bf16* h) {
    for (int m = F.gw; m < M; m += F.ngw) rms_row_to_bf16(x + (size_t)m * D_MODEL, g, h + (size_t)m * D_MODEL, F.lane);
}
#ifdef CPU_EMU
#define LAS
#define DEVFN inline
typedef short bf16x8 __attribute__((ext_vector_type(8)));
typedef short s16x4 __attribute__((ext_vector_type(4)));
typedef float f32x16 __attribute__((ext_vector_type(16)));
typedef unsigned u32x4 __attribute__((ext_vector_type(4)));
#define MFMA32(a, b, c) emu::mfma32(a, b, c)
#define MFMA16F32(a, b, c) emu::mfma16f32(a, b, c)
#define LDS_TR16(p) emu::tr16(p)
#define BPERM(i, v) emu::bpermute(i, v)
#define SYNC() emu::bsync()
#define ANY(p) emu::any(p)
#define CVTPK(lo, hi) emu::cvt_pk_bf16(lo, hi)
#define EXP2(x) exp2f(x)
#define RCP(x) (1.0f / (x))
#define UNIFORM(x) (x)
#define OPAQUE_V(x) ((void)0)
#define GLDS16(gp, lp) memcpy((unsigned char*)(lp) + 16 * emu::lane, (const void*)(gp), 16)
#define WAITV(n) ((void)0)
#define BAR_RAW() emu::bsync()
#else
#define DEVFN __device__ __forceinline__
typedef short bf16x8 __attribute__((ext_vector_type(8)));
typedef short s16x4 __attribute__((ext_vector_type(4)));
typedef float f32x16 __attribute__((ext_vector_type(16)));
typedef unsigned u32x4 __attribute__((ext_vector_type(4)));
#define MFMA32(a, b, c) __builtin_amdgcn_mfma_f32_32x32x16_bf16(a, b, c, 0, 0, 0)
#define MFMA16F32(a, b, c) __builtin_amdgcn_mfma_f32_16x16x4f32(a, b, c, 0, 0, 0)
#define LDS_TR16(p) __builtin_amdgcn_ds_read_tr16_b64_v4i16((LAS s16x4*)(p))
#define BPERM(i, v) __builtin_amdgcn_ds_bpermute(i, v)
#define SYNC() __syncthreads()
#define ANY(p) (__builtin_amdgcn_ballot_w64(p) != 0ull)
typedef __bf16 bf16x2_t __attribute__((ext_vector_type(2)));
typedef float f32x2_t __attribute__((ext_vector_type(2)));
DEVFN unsigned cvt_pk_visible(float lo, float hi) { const f32x2_t v = {lo, hi}; return __builtin_bit_cast(unsigned, __builtin_convertvector(v, bf16x2_t)); }
#define CVTPK(lo, hi) cvt_pk_visible(lo, hi)
#define EXP2(x) __builtin_amdgcn_exp2f(x)
#define RCP(x) __builtin_amdgcn_rcpf(x)
#define UNIFORM(x) __builtin_amdgcn_readfirstlane(x)
#define OPAQUE_V(x) asm volatile("" : "+v"(x))
DEVFN void glds16_asm(const void* gsrc, unsigned lds_dst) { unsigned keep;
    asm volatile("s_mov_b32 %0, m0\n\ts_mov_b32 m0, %2\n\ts_nop 0\n\tglobal_load_lds_dwordx4 %1, off\n\ts_mov_b32 m0, %0" : "=&s"(keep) : "v"(gsrc), "s"(lds_dst) : "memory"); }
#define GLDS16(gp, lp) glds16_asm((const void*)(gp), (unsigned)__builtin_amdgcn_readfirstlane((int)(unsigned)(size_t)(lp)))
#define WAITV(n) asm volatile("s_waitcnt vmcnt(" #n ")" ::: "memory")
#define BAR_RAW() do { asm volatile("s_waitcnt lgkmcnt(0)" ::: "memory"); __builtin_amdgcn_s_barrier(); asm volatile("" ::: "memory"); } while (0)
#endif
DEVFN float bperm_f(int byte_idx, float v) { return __builtin_bit_cast(float, BPERM(byte_idx, __builtin_bit_cast(int, v))); }
DEVFN unsigned off_b(unsigned row, unsigned ch) { return 256u * row + 16u * (ch ^ (((row & 3) << 2) | ((row >> 2) & 3))); }

constexpr int AT_QROWS = 128, AT_KT = 64;
#ifndef AT_SHIFT_THR
#define AT_SHIFT_THR 60.f
#endif
DEVFN void attn_phase(LAS unsigned char* lds, const bf16* qkv, bf16* Y, const float* subln, const unsigned* kmax2  , float lam, float omli, int tid, int bid, int G) {
    const int lane = tid & 63, wave = UNIFORM(tid >> 6), comp = wave & 1, grp = wave >> 2, qg = wave >> 1, h5 = lane >> 5, l31 = lane & 31;
    constexpr int NQB = M / AT_QROWS, NU = NQB * ATT_HEADS;
    const unsigned blk = (lane >> 4) & 1, qq = (lane & 15) >> 2, pp = lane & 3;
    unsigned vb8[2][4];
#pragma unroll
    for (int t8 = 0; t8 < 2; ++t8)
#pragma unroll
        for (int eb = 0; eb < 4; ++eb) vb8[t8][eb] = off_b(4 * h5 + qq + 8 * t8, 4 * eb + 2 * blk + (pp >> 1)) + 8 * (pp & 1);
    for (int un = bid; un < NU; un += G) {
        const int head = un % ATT_HEADS, qblk = un / ATT_HEADS, m0 = qblk * AT_QROWS;
        const int row0 = m0 < BATCH * SEQ ? (m0 / SEQ) * SEQ : BATCH * SEQ, len = m0 < BATCH * SEQ ? SEQ : DEC_SEQ, ntiles = len / AT_KT;
        const int myrow = m0 + 32 * qg + l31;
        bf16x8 qf[4];
#pragma unroll
        for (int ks = 0; ks < 4; ++ks) qf[ks] = *(const bf16x8*)(qkv + (size_t)myrow * QKV_N + (head * 2 + comp) * DH + 16 * ks + 8 * h5);
        f32x16 O[4];
#pragma unroll
        for (int eb = 0; eb < 4; ++eb)
#pragma unroll
            for (int r = 0; r < 16; ++r) O[eb][r] = 0.f;
        float lrun = 0.f; f32x16 Cneg;
        { float qs2 = 0.f;
#pragma unroll
          for (int ks = 0; ks < 4; ++ks)
#pragma unroll
              for (int e = 0; e < 8; ++e) { const float qv = bf2f((unsigned)(unsigned short)qf[ks][e]); qs2 += qv * qv; }
          qs2 += bperm_f((lane ^ 32) << 2, qs2);
          const int sq = m0 < BATCH * SEQ ? m0 / SEQ : BATCH; const float km2 = __builtin_bit_cast(float, kmax2[sq * 2 * ATT_HEADS + head * 2 + comp]);
          const float mneg = -sqrtf(qs2 * km2) * 1.01f;
#pragma unroll
          for (int r = 0; r < 16; ++r) Cneg[r] = mneg; }
        unsigned goff[2];
#pragma unroll
        for (int jq = 0; jq < 2; ++jq) { const int q = 2 * wave + jq, prow = 4 * q + (lane >> 4), pch = (lane & 15) ^ ((((lane >> 4) & 3) << 2) | (q & 3)); goff[jq] = (unsigned)((prow * QKV_N + pch * 8) * 2); }
        const unsigned char* gkb = (const unsigned char*)(qkv + (size_t)row0 * QKV_N + D_MODEL + head * 2 * DH);
        const unsigned char* gvb = (const unsigned char*)(qkv + (size_t)row0 * QKV_N + 2 * D_MODEL + head * DV);
#define AT_DMA(tile) do { const size_t tb_ = (size_t)(tile) * AT_KT * QKV_N * 2; LAS unsigned char* sl_ = lds + (unsigned)((tile) & 3) * 32768u + (unsigned)wave * 2048u; \
            GLDS16(gkb + tb_ + goff[0], sl_); GLDS16(gkb + tb_ + goff[1], sl_ + 1024); GLDS16(gvb + tb_ + goff[0], sl_ + 16384); GLDS16(gvb + tb_ + goff[1], sl_ + 16384 + 1024); } while (0)
        AT_DMA(0);
        if (ntiles > 1) { AT_DMA(1); WAITV(4); } else { WAITV(0); }
        BAR_RAW();
        unsigned pk[2][8];
#define AT_LOADV(dst, g) do { _Pragma("unroll") for (int eb = 0; eb < 4; ++eb) { dst[2 * eb] = LDS_TR16(vp_[0][eb] + 4096 * (g)); dst[2 * eb + 1] = LDS_TR16(vp_[1][eb] + 4096 * (g)); } } while (0)
#define AT_MMA4(src, g) do { const u32x4 pw = (u32x4){pk[(g) >> 1][4 * ((g) & 1)], pk[(g) >> 1][4 * ((g) & 1) + 1], pk[(g) >> 1][4 * ((g) & 1) + 2], pk[(g) >> 1][4 * ((g) & 1) + 3]}; const bf16x8 pf = __builtin_bit_cast(bf16x8, pw); \
                _Pragma("unroll") for (int eb = 0; eb < 4; ++eb) { const bf16x8 vf = __builtin_shufflevector(src[2 * eb], src[2 * eb + 1], 0, 1, 2, 3, 4, 5, 6, 7); \
                    O[eb] = MFMA32(vf, pf, O[eb]); } } while (0)
#define AT_PV(slot) do { const LAS unsigned char* Vb_ = lds + (unsigned)(slot) * 32768u + 16384u; s16x4 va[8], vb[8]; const LAS unsigned char* vp_[2][4]; \
            _Pragma("unroll") for (int t8 = 0; t8 < 2; ++t8) _Pragma("unroll") for (int eb = 0; eb < 4; ++eb) vp_[t8][eb] = Vb_ + vb8[t8][eb];     \
            AT_LOADV(va, 0); AT_LOADV(vb, 1); AT_MMA4(va, 0); AT_LOADV(va, 2); AT_MMA4(vb, 1); AT_LOADV(vb, 3); AT_MMA4(va, 2); AT_MMA4(vb, 3); } while (0)
#define AT_TILELOOP(C0_) \
        for (int t = 0; t < ntiles; ++t) { \
            const bool more = t + 2 < ntiles; \
            if (more) AT_DMA(t + 2); \
            if (grp == 1 && t > 0) AT_PV((t - 1) & 3); \
            const LAS unsigned char* Kb = lds + (unsigned)(t & 3) * 32768u; \
            f32x16 S[2]; bf16x8 kfr[2][4]; \
        _Pragma("unroll") \
            for (int kb = 0; kb < 2; ++kb) \
        _Pragma("unroll") \
                for (int ks = 0; ks < 4; ++ks) kfr[kb][ks] = *(const LAS bf16x8*)(Kb + off_b(32 * kb + l31, 8 * comp + 2 * ks + h5)); \
        _Pragma("unroll") \
            for (int kb = 0; kb < 2; ++kb) S[kb] = MFMA32(kfr[kb][0], qf[0], C0_); \
        _Pragma("unroll") \
            for (int ks = 1; ks < 4; ++ks) \
        _Pragma("unroll") \
                for (int kb = 0; kb < 2; ++kb) S[kb] = MFMA32(kfr[kb][ks], qf[ks], S[kb]); \
            float psum = 0.f; \
        _Pragma("unroll") \
            for (int kb = 0; kb < 2; ++kb) \
        _Pragma("unroll") \
                for (int i = 0; i < 8; ++i) { const float p0 = EXP2(S[kb][2 * i]), p1 = EXP2(S[kb][2 * i + 1]); psum += p0 + p1; pk[kb][i] = CVTPK(p0, p1); } \
            lrun += psum; \
            if (grp == 0) AT_PV(t & 3); \
            if (more) WAITV(4); else WAITV(0); \
            BAR_RAW(); \
        }
        { const f32x16 Z16 = {0.f, 0.f, 0.f, 0.f, 0.f, 0.f, 0.f, 0.f, 0.f, 0.f, 0.f, 0.f, 0.f, 0.f, 0.f, 0.f};
          if (ANY(Cneg[0] < -(AT_SHIFT_THR))) { AT_TILELOOP(Cneg) } else { AT_TILELOOP(Z16) } }
#undef AT_TILELOOP
        if (grp == 1) AT_PV((ntiles - 1) & 3);
        SYNC();
#undef AT_LOADV
#undef AT_MMA4
#undef AT_PV
#undef AT_DMA
        const float ltot = lrun + bperm_f((lane ^ 32) << 2, lrun), inv = RCP(ltot);
        LAS float* xch = (LAS float*)(lds + qg * 16384);
        if (comp == 1) {
#pragma unroll
            for (int eb = 0; eb < 4; ++eb)
#pragma unroll
                for (int r = 0; r < 16; ++r) xch[(eb * 16 + r) * 64 + lane] = O[eb][r] * inv;
        }
        SYNC();
        if (comp == 0) {
            float ss = 0.f;
#pragma unroll
            for (int eb = 0; eb < 4; ++eb)
#pragma unroll
                for (int r = 0; r < 16; ++r) { const float d = O[eb][r] * inv - lam * xch[(eb * 16 + r) * 64 + lane]; O[eb][r] = d; ss += d * d; }
            ss += bperm_f((lane ^ 32) << 2, ss);
            const float rs = omli / sqrtf(ss * (1.0f / DV) + NORM_EPS);
            bf16* yrow = Y + (size_t)myrow * D_MODEL + head * DV;
#pragma unroll
            for (int eb = 0; eb < 4; ++eb)
#pragma unroll
                for (int g4 = 0; g4 < 4; ++g4) { const int e0 = 32 * eb + 8 * g4 + 4 * h5;
                    const float y0 = O[eb][4 * g4 + 0] * rs * subln[e0 + 0], y1 = O[eb][4 * g4 + 1] * rs * subln[e0 + 1], y2 = O[eb][4 * g4 + 2] * rs * subln[e0 + 2], y3 = O[eb][4 * g4 + 3] * rs * subln[e0 + 3];
                    *(unsigned long long*)(yrow + e0) = (unsigned long long)CVTPK(y0, y1) | ((unsigned long long)CVTPK(y2, y3) << 32); }
        }
        SYNC();
    }
}
namespace pg8 {
typedef unsigned long long rowss_t;
constexpr float ROWSS_SCALE = 16777216.0f;
#ifdef CPU_EMU
#define ATOMIC_ADD_U64(p, v) __atomic_fetch_add(p, v, __ATOMIC_RELAXED)
#define ATOMIC_MAX_U32(p, v) do { unsigned o_ = __atomic_load_n(p, __ATOMIC_RELAXED); while (o_ < (v) && !__atomic_compare_exchange_n(p, &o_, (v), true, __ATOMIC_RELAXED, __ATOMIC_RELAXED)) {} } while (0)
#define RSQ(x) (1.0f / sqrtf(x))
#define ROWGROUP_FENCE() ((void)0)
#define EPI_SCHED_FENCE() ((void)0)
#else
#define ATOMIC_ADD_U64(p, v) atomicAdd(p, v)
#define ATOMIC_MAX_U32(p, v) atomicMax(p, v)
#define RSQ(x) __builtin_amdgcn_rsqf(x)
#define ROWGROUP_FENCE() asm volatile("" ::: "memory")
#define EPI_SCHED_FENCE() __builtin_amdgcn_sched_barrier(0)
#endif
struct EpiResidNorm {
    static constexpr bool PERM = true, AFTER_DRAIN = false;
    float* X; bf16_t* XB; rowss_t* rowss; int ldc; float scale;
    DEVFN void operator()(const f32x4 (&acc)[2][2][4][2], const Unit& u, int wr, int wc, int fr, int fq) const {
        const int row0 = u.pm * BM + wr * 64 + fr, col0 = u.pn * BM + wc * 32 + 8 * fq, lane = fr + 16 * fq;
#pragma unroll
        for (int ai = 0; ai < 2; ++ai)
#pragma unroll
            for (int m = 0; m < 4; ++m) { const int row = row0 + ai * HALF + m * 16; float* rowp = X + (size_t)row * ldc + col0; bf16_t* rowb = XB + (size_t)row * ldc + col0;
                f32x4 v[2][2];
#pragma unroll
                for (int bj = 0; bj < 2; ++bj)
#pragma unroll
                    for (int n = 0; n < 2; ++n) v[bj][n] = *(const f32x4*)(rowp + bj * HALF + n * 4);
                float ss = 0.f;
#pragma unroll
                for (int bj = 0; bj < 2; ++bj) { f32x4 o[2];
#pragma unroll
                    for (int n = 0; n < 2; ++n) { o[n] = v[bj][n] + acc[ai][bj][m][n] * scale; *(f32x4*)(rowp + bj * HALF + n * 4) = o[n];
                        ss += (o[n][0] * o[n][0] + o[n][1] * o[n][1]) + (o[n][2] * o[n][2] + o[n][3] * o[n][3]); }
                    *(u32x4*)(rowb + bj * HALF) = (u32x4){CVTPK(o[0][0], o[0][1]), CVTPK(o[0][2], o[0][3]), CVTPK(o[1][0], o[1][1]), CVTPK(o[1][2], o[1][3])}; }
                ss += bperm_f((lane ^ 16) << 2, ss); ss += bperm_f((lane ^ 32) << 2, ss);
                if (fq == 0) ATOMIC_ADD_U64(rowss + row, (rowss_t)(ss * ROWSS_SCALE)); ROWGROUP_FENCE(); }
    }
};
DEVFN size_t blk_off(int row, int col, int K) { return ((size_t)((row >> 8) * (K >> 6) + (col >> 6)) * 256 + (row & 255)) * 64 + (col & 63); }
DEVFN float rstd_of(const rowss_t* rowss, int row) { return RSQ((float)rowss[row] * (1.0f / (ROWSS_SCALE * D_MODEL)) + NORM_EPS); }
DEVFN void rstd8(const rowss_t* rowss, int rowbase, int fr, int fq, float (&rs)[2][4]) {
    const int lane = fr + 16 * fq; const float r0 = rstd_of(rowss, rowbase + lane), r1 = rstd_of(rowss, rowbase + HALF + lane);
#pragma unroll
    for (int m = 0; m < 4; ++m) { rs[0][m] = bperm_f((m * 16 + fr) << 2, r0); rs[1][m] = bperm_f((m * 16 + fr) << 2, r1); }
}
struct EpiSwiGLUNorm {
    static constexpr bool PERM = true, AFTER_DRAIN = false;
    bf16_t* O; int ldc; const rowss_t* rowss;
    DEVFN void operator()(const f32x4 (&acc)[2][2][4][2], const Unit& u, int wr, int wc, int fr, int fq) const {
        const int row0 = u.pm * BM + wr * 64 + fr, col0 = u.pn * HALF + wc * 32 + 8 * fq;
        float rsv[2][4]; rstd8(rowss, u.pm * BM + wr * 64, fr, fq, rsv);
#pragma unroll
        for (int ai = 0; ai < 2; ++ai)
#pragma unroll
            for (int m = 0; m < 4; ++m) { const int row = row0 + ai * HALF + m * 16; const float rs = rsv[ai][m]; float g[8];
#pragma unroll
                for (int n = 0; n < 2; ++n)
#pragma unroll
                    for (int j = 0; j < 4; ++j) { const float h1 = acc[ai][0][m][n][j] * rs, h3 = acc[ai][1][m][n][j] * rs; g[4 * n + j] = h1 * RCP(1.0f + EXP2(-1.4426950408889634f * h1)) * h3; }
                *(u32x4*)(O + blk_off(row, col0, ldc)) = (u32x4){CVTPK(g[0], g[1]), CVTPK(g[2], g[3]), CVTPK(g[4], g[5]), CVTPK(g[6], g[7])}; }
    }
};
struct EpiBf16Norm {
    static constexpr bool PERM = true, AFTER_DRAIN = false;
    bf16_t* O; int ldc; const rowss_t* rowss;
    DEVFN void operator()(const f32x4 (&acc)[2][2][4][2], const Unit& u, int wr, int wc, int fr, int fq) const {
        const int row0 = u.pm * BM + wr * 64 + fr, col0 = u.pn * BM + wc * 32 + 8 * fq;
        float rsv[2][4]; rstd8(rowss, u.pm * BM + wr * 64, fr, fq, rsv);
#pragma unroll
        for (int ai = 0; ai < 2; ++ai)
#pragma unroll
            for (int m = 0; m < 4; ++m) { const int row = row0 + ai * HALF + m * 16; const float rs = rsv[ai][m];
#pragma unroll
                for (int bj = 0; bj < 2; ++bj) { const f32x4 v0 = acc[ai][bj][m][0] * rs, v1 = acc[ai][bj][m][1] * rs;
                    *(u32x4*)(O + (size_t)row * ldc + col0 + bj * HALF) = (u32x4){CVTPK(v0[0], v0[1]), CVTPK(v0[2], v0[3]), CVTPK(v1[0], v1[1]), CVTPK(v1[2], v1[3])}; } }
    }
};
struct EpiQKVRope {
    static constexpr bool PERM = true, AFTER_DRAIN = false;
    bf16_t* O; int ldc; const rowss_t* rowss; const float* ropetab  ; float qscale; unsigned* kmax2  ;
    DEVFN void operator()(const f32x4 (&acc)[2][2][4][2], const Unit& u, int wr, int wc, int fr, int fq) const {
        const int row0 = u.pm * BM + wr * 64 + fr;
        float rsv[2][4]; rstd8(rowss, u.pm * BM + wr * 64, fr, fq, rsv);
        if (u.pn >= 2 * D_MODEL / 256) {
            const int col0 = u.pn * BM + wc * 32 + 8 * fq;
#pragma unroll
            for (int ai = 0; ai < 2; ++ai)
#pragma unroll
                for (int m = 0; m < 4; ++m) { const int row = row0 + ai * HALF + m * 16; const float rs = rsv[ai][m];
#pragma unroll
                    for (int bj = 0; bj < 2; ++bj) { const f32x4 v0 = acc[ai][bj][m][0] * rs, v1 = acc[ai][bj][m][1] * rs;
                        *(u32x4*)(O + (size_t)row * ldc + col0 + bj * HALF) = (u32x4){CVTPK(v0[0], v0[1]), CVTPK(v0[2], v0[3]), CVTPK(v1[0], v1[1]), CVTPK(v1[2], v1[3])}; } }
            return; }
        const float qs = u.pn < D_MODEL / 256 ? qscale : 1.0f; const int colb = (u.pn * 4 + wc) * DH + 8 * fq;
        const bool is_k = u.pn >= D_MODEL / 256; float kmx = 0.f; const int lane = fr + 16 * fq;
#pragma unroll
        for (int ai = 0; ai < 2; ++ai)
#pragma unroll
            for (int m = 0; m < 4; ++m) { const int row = row0 + ai * HALF + m * 16; const float rs = rsv[ai][m] * qs;
                const int t = row < BATCH * SEQ ? row % SEQ : row - BATCH * SEQ; const f32x4* tb = (const f32x4*)(ropetab + ((size_t)t * (DH / 2) + 8 * fq) * 2);
                float lo[8], hi[8];
#pragma unroll
                for (int q = 0; q < 4; ++q) { const f32x4 cs = tb[q];
#pragma unroll
                    for (int e = 0; e < 2; ++e) { const int d = 2 * q + e; const float c = cs[2 * e], s = cs[2 * e + 1], l = acc[ai][0][m][d >> 2][d & 3] * rs, h = acc[ai][1][m][d >> 2][d & 3] * rs;
                        lo[d] = l * c - h * s; hi[d] = h * c + l * s; } }
                bf16_t* op = O + (size_t)row * ldc + colb;
                *(u32x4*)op = (u32x4){CVTPK(lo[0], lo[1]), CVTPK(lo[2], lo[3]), CVTPK(lo[4], lo[5]), CVTPK(lo[6], lo[7])};
                *(u32x4*)(op + DH / 2) = (u32x4){CVTPK(hi[0], hi[1]), CVTPK(hi[2], hi[3]), CVTPK(hi[4], hi[5]), CVTPK(hi[6], hi[7])};
                if (is_k) { float ss = 0.f;
#pragma unroll
                    for (int d = 0; d < 8; ++d) ss += lo[d] * lo[d] + hi[d] * hi[d];
                    ss += bperm_f((lane ^ 16) << 2, ss); ss += bperm_f((lane ^ 32) << 2, ss); kmx = fmaxf(kmx, ss); }
                ROWGROUP_FENCE(); }
        if (is_k) {
#pragma unroll
            for (int o = 1; o < 16; o <<= 1) kmx = fmaxf(kmx, bperm_f((lane ^ o) << 2, kmx));
            const int r0 = u.pm * BM, sq = r0 < BATCH * SEQ ? r0 / SEQ : BATCH;
            if (lane == 0) ATOMIC_MAX_U32(kmax2 + sq * 2 * ATT_HEADS + (u.pn * 4 + wc - 2 * ATT_HEADS), __builtin_bit_cast(unsigned, kmx)); }
    }
};
}
constexpr int HY_PAD = 32;
template <int L> struct HyGeom { static constexpr int NI = L / 32, NCB = L / 1024, PLANE = (L / 32 + 2 * HY_PAD) * 16, UBYTES = 4 * PLANE; };
static_assert(SEQ % 1024 == 0 && DEC_SEQ % 1024 == 0 && DEC_SEQ / 1024 <= 8 && 2 * (SEQ / 1024) <= 8, "hyena conv geometry");
constexpr int HY_KOFF = 64  , HY_KCOPY = 2 * DEC_SEQ * 2 + 64, HY_UOFF = HY_KOFF + 2 * HY_KCOPY;
constexpr int HY_UOFF2 = HY_UOFF + HyGeom<DEC_SEQ>::UBYTES;
static_assert(HY_UOFF2 + BATCH * HyGeom<SEQ>::UBYTES <= 131072, "hyena LDS map");

template <int L> DEVFN void hy_stage_u(LAS unsigned char* ubase, const bf16* ut_seq, int tid) {
    typedef HyGeom<L> Gm;
    for (int p = tid; p < L / 8; p += 512) { const int jb = p >> 1, half = p & 1; const u32x4 v = *(const u32x4*)(ut_seq + 8 * p);
        *(LAS u32x4*)(ubase + ((jb & 1) * 2 + half) * Gm::PLANE + 16 * ((jb >> 1) + HY_PAD)) = v; }
}
template <int L> DEVFN void hy_zero_pads(LAS unsigned char* ubase, int tid) {
    typedef HyGeom<L> Gm;
    unsigned zz = 0u; OPAQUE_V(zz);
    for (int z = tid; z < 4 * 2 * HY_PAD; z += 512) { const int pl = z / (2 * HY_PAD), k = z % (2 * HY_PAD);
        *(LAS u32x4*)(ubase + pl * Gm::PLANE + 16 * (k < HY_PAD ? k : (L / 32) + k)) = (u32x4){zz, zz, zz, zz}; }
}
template <int NP> struct HyFilt { u32x4 pc[NP]; unsigned nx[NP]; };
template <int L, int NP> DEVFN void hy_filter_load(HyFilt<NP>& F, const bf16* fsrc, int tid) {
    static_assert(NP * 512 * 8 >= 2 * L, "pieces per thread");
#pragma unroll
    for (int k = 0; k < NP; ++k) { const int p = tid + 512 * k; if (p < 2 * L / 8) { F.pc[k] = *(const u32x4*)(fsrc + 8 * p); F.nx[k] = p + 1 < 2 * L / 8 ? *(const unsigned*)(fsrc + 8 * p + 8) : 0u; } }
}
template <int L, int NP> DEVFN void hy_filter_write(LAS unsigned char* lds, const HyFilt<NP>& F, int tid) {
#pragma unroll
    for (int k = 0; k < NP; ++k) { const int p = tid + 512 * k; if (p >= 2 * L / 8) continue; const u32x4 v = F.pc[k];
        *(LAS u32x4*)(lds + HY_KOFF + 16 * p) = v;
        *(LAS u32x4*)(lds + HY_KOFF + HY_KCOPY + 16 * p) = (u32x4){(v[0] >> 16) | (v[1] << 16), (v[1] >> 16) | (v[2] << 16), (v[2] >> 16) | (v[3] << 16), (v[3] >> 16) | (F.nx[k] << 16)}; }
}
template <int L> DEVFN void hy_wave_conv(const LAS unsigned char* kflds, const LAS unsigned char* ubase, int cb, int lane, f32x16& acc) {
    typedef HyGeom<L> Gm;
    static_assert((L / 16) % 4 == 0, "first step odd, step count 2 mod 4");
    const int n = lane & 31, h5 = lane >> 5, par = (n + 1) & 1;
#pragma unroll
    for (int r = 0; r < 16; ++r) acc[r] = 0.f;
    const int mlo = 64 * cb - (L / 16 - 1), mhi = 64 * cb + 62, nst = mhi - mlo + 1, ngr = nst >> 2;
    const int mu0 = (mlo + 1) >> 1;
    const volatile LAS unsigned* pA = (const volatile LAS unsigned*)(kflds + par * HY_KCOPY) + ((L - 1 - 16 * mlo - n + 8 * h5 - par) >> 1) - 24;
    const LAS unsigned char* pO = ubase + (2 + h5) * Gm::PLANE + 16 * (32 * cb + n - mu0 + HY_PAD) - 16;
    const LAS unsigned char* pE = ubase + (0 + h5) * Gm::PLANE + 16 * (32 * cb + n - mu0 + HY_PAD) - 16;
#define HY_LDA(A, k) do { const unsigned w0 = pA[24 - 8 * (k)], w1 = pA[25 - 8 * (k)], w2 = pA[26 - 8 * (k)], w3 = pA[27 - 8 * (k)]; A = __builtin_bit_cast(bf16x8, (u32x4){w0, w1, w2, w3}); } while (0)
#define HY_LDG(A, B) do { HY_LDA(A[0], 0); B[0] = *(const LAS bf16x8*)(pO + 16); HY_LDA(A[1], 1); B[1] = *(const LAS bf16x8*)(pE + 16); \
        HY_LDA(A[2], 2); B[2] = *(const LAS bf16x8*)pO; HY_LDA(A[3], 3); B[3] = *(const LAS bf16x8*)pE; } while (0)
    bf16x8 fa[4], fb[4], na[4], nb[4];
    HY_LDG(fa, fb);
    for (int gi = 0; gi < ngr; ++gi) {
        pA -= 32; pO -= 32; pE -= 32;
        HY_LDG(na, nb);
#pragma unroll
        for (int k = 0; k < 4; ++k) acc = MFMA32(fa[k], fb[k], acc);
#pragma unroll
        for (int k = 0; k < 4; ++k) { fa[k] = na[k]; fb[k] = nb[k]; }
    }
    acc = MFMA32(fa[0], fb[0], acc); acc = MFMA32(fa[1], fb[1], acc);
#undef HY_LDA
#undef HY_LDG
}
struct HyEpi { unsigned long long uu[4], xx[4]; };
DEVFN void hy_epi_load(HyEpi& E, const bf16* ut_seq, const bf16* x0t_seq, int cb, int lane) {
    const int n = lane & 31, h5 = lane >> 5;
#pragma unroll
    for (int g4 = 0; g4 < 4; ++g4) { const int t0 = 32 * (32 * cb + n) + 8 * g4 + 4 * h5; E.uu[g4] = *(const unsigned long long*)(ut_seq + t0); E.xx[g4] = *(const unsigned long long*)(x0t_seq + t0); }
}
DEVFN void hy_wave_store(const f32x16& acc, const HyEpi& E, bf16* yt_seq, float bias, int cb, int lane) {
    const int n = lane & 31, h5 = lane >> 5;
#pragma unroll
    for (int g4 = 0; g4 < 4; ++g4) { const int t0 = 32 * (32 * cb + n) + 8 * g4 + 4 * h5; const unsigned long long uu = E.uu[g4], xx = E.xx[g4];
        float y[4];
#pragma unroll
        for (int k = 0; k < 4; ++k) { const float uv = bf2f((unsigned)((uu >> (16 * k)) & 0xffffu)), xv = bf2f((unsigned)((xx >> (16 * k)) & 0xffffu)); y[k] = xv * (acc[4 * g4 + k] + bias * uv); }
        *(unsigned long long*)(yt_seq + t0) = (unsigned long long)CVTPK(y[0], y[1]) | ((unsigned long long)CVTPK(y[2], y[3]) << 32); }
}
DEVFN void hyena_conv_phase(LAS unsigned char* lds, const bf16* f8, const bf16* f4, const bf16* ut, const bf16* x0t, bf16* yt, const float* hbias, int tid, int bid, int G) {
    const int lane = tid & 63, wave = UNIFORM(tid >> 6);
    constexpr int NP8 = (2 * DEC_SEQ / 8 + 511) / 512, NP4 = (2 * SEQ / 8 + 511) / 512, NCB4 = HyGeom<SEQ>::NCB;
    hy_zero_pads<DEC_SEQ>(lds + HY_UOFF, tid);
    for (int b = 0; b < BATCH; ++b) hy_zero_pads<SEQ>(lds + HY_UOFF2 + b * HyGeom<SEQ>::UBYTES, tid);
    HyFilt<NP8> F8; HyFilt<NP4> F4;
    if (bid < HW) { hy_filter_load<DEC_SEQ, NP8>(F8, f8 + (size_t)bid * 2 * DEC_SEQ, tid); hy_stage_u<DEC_SEQ>(lds + HY_UOFF, ut + (size_t)bid * M + BATCH * SEQ, tid); }
    for (int c = bid; c < HW; c += G) {
        const float bias = hbias[c];
        hy_filter_write<DEC_SEQ, NP8>(lds, F8, tid);
        SYNC();
        hy_filter_load<SEQ, NP4>(F4, f4 + (size_t)c * 2 * SEQ, tid);
        for (int b = 0; b < BATCH; ++b) hy_stage_u<SEQ>(lds + HY_UOFF2 + b * HyGeom<SEQ>::UBYTES, ut + (size_t)c * M + b * SEQ, tid);
        if (wave < HyGeom<DEC_SEQ>::NCB) { f32x16 acc; HyEpi E; hy_epi_load(E, ut + (size_t)c * M + BATCH * SEQ, x0t + (size_t)c * M + BATCH * SEQ, wave, lane);
            hy_wave_conv<DEC_SEQ>(lds + HY_KOFF, lds + HY_UOFF, wave, lane, acc);
            hy_wave_store(acc, E, yt + (size_t)c * M + BATCH * SEQ, bias, wave, lane); }
        SYNC();
        hy_filter_write<SEQ, NP4>(lds, F4, tid);
        SYNC();
        const int cn = c + G;
        if (cn < HW) { hy_filter_load<DEC_SEQ, NP8>(F8, f8 + (size_t)cn * 2 * DEC_SEQ, tid); hy_stage_u<DEC_SEQ>(lds + HY_UOFF, ut + (size_t)cn * M + BATCH * SEQ, tid); }
        if (wave < BATCH * NCB4) { const int sq = wave / NCB4, cb = wave % NCB4; f32x16 acc; HyEpi E; hy_epi_load(E, ut + (size_t)c * M + sq * SEQ, x0t + (size_t)c * M + sq * SEQ, cb, lane);
            hy_wave_conv<SEQ>(lds + HY_KOFF, lds + HY_UOFF2 + sq * HyGeom<SEQ>::UBYTES, cb, lane, acc);
            hy_wave_store(acc, E, yt + (size_t)c * M + sq * SEQ, bias, cb, lane); }
        SYNC();
    }
}
DEVFN void hyena_pre_phase(LAS unsigned char* lds, const bf16* p  , const float* cw  , const float* cb3  , bf16* ut, bf16* x0t, int tid, int bid, int G) {
    constexpr int CB = 64, NU = (M / 128) * (HW / CB);
    LAS unsigned short* tu = (LAS unsigned short*)lds; LAS unsigned short* tx = tu + CB * 136;
    LAS float* Lc = (LAS float*)(lds + 2 * CB * 136 * 2);
    int ckey = -1;
    for (int un = bid; un < NU; un += G) {
        const int m0 = (un / (HW / CB)) * 128, c0 = (un % (HW / CB)) * CB, cg = tid & 7;
        if (ckey != c0) { ckey = c0;
            for (int i = tid; i < 12 * CB; i += 512) { const int jk = i / CB, cc = i % CB, j = jk / 3, k = jk % 3; Lc[i] = j < 3 ? cw[j * (3 * HW) + k * HW + c0 + cc] : cb3[k * HW + c0 + cc]; }
            SYNC(); }
#pragma unroll
        for (int hf = 0; hf < 2; ++hf) { const int r = (tid >> 3) + 64 * hf, m = m0 + r;
            const int row0 = m < BATCH * SEQ ? (m / SEQ) * SEQ : BATCH * SEQ, len = m < BATCH * SEQ ? SEQ : DEC_SEQ, t = m - row0;
            u32x4 tap[3][3];
#pragma unroll
            for (int k = 0; k < 3; ++k)
#pragma unroll
                for (int j = 0; j < 3; ++j) { const int tt = t + j - 1; tap[k][j] = (tt >= 0 && tt < len) ? *(const u32x4*)(p + (size_t)(row0 + tt) * IN_EVEN + k * HW + c0 + 8 * cg) : (u32x4){0u, 0u, 0u, 0u}; }
            float res[3][8];
#pragma unroll
            for (int k = 0; k < 3; ++k) {
                { const f32x4 b0 = *(const LAS f32x4*)(Lc + (9 + k) * CB + 8 * cg), b1 = *(const LAS f32x4*)(Lc + (9 + k) * CB + 8 * cg + 4);
#pragma unroll
                  for (int e = 0; e < 4; ++e) { res[k][e] = b0[e]; res[k][4 + e] = b1[e]; } }
#pragma unroll
                for (int j = 0; j < 3; ++j) { const u32x4 v = tap[k][j]; const f32x4 w0 = *(const LAS f32x4*)(Lc + (j * 3 + k) * CB + 8 * cg), w1 = *(const LAS f32x4*)(Lc + (j * 3 + k) * CB + 8 * cg + 4);
#pragma unroll
                    for (int e = 0; e < 8; ++e) { const unsigned w = v[e >> 1]; res[k][e] += bf2f((e & 1) ? (w >> 16) : (w & 0xffffu)) * (e < 4 ? w0[e & 3] : w1[e & 3]); } } }
#pragma unroll
            for (int e = 0; e < 8; ++e) { tu[(8 * cg + e) * 136 + r] = (unsigned short)f2bf(res[2][e] * res[1][e]); tx[(8 * cg + e) * 136 + r] = (unsigned short)f2bf(res[0][e]); } }
        SYNC();
#pragma unroll
        for (int hf = 0; hf < 2; ++hf) { const int ch = (tid >> 4) + 32 * hf, pc = tid & 15;
          *(u32x4*)(ut + (size_t)(c0 + ch) * M + m0 + 8 * pc) = *(const LAS u32x4*)(tu + ch * 136 + 8 * pc);
          *(u32x4*)(x0t + (size_t)(c0 + ch) * M + m0 + 8 * pc) = *(const LAS u32x4*)(tx + ch * 136 + 8 * pc); }
        SYNC();
    }
}
DEVFN void hyena_post_phase(LAS unsigned char* lds, const bf16* yt, bf16* Y, int tid, int bid, int G) {
    constexpr int CB = 64, NU = (M / 128) * (HW / CB);
    LAS unsigned short* ty = (LAS unsigned short*)lds;
    for (int un = bid; un < NU; un += G) {
        const int m0 = (un / (HW / CB)) * 128, c0 = (un % (HW / CB)) * CB;
        u32x4 v[2];
#pragma unroll
        for (int hf = 0; hf < 2; ++hf) v[hf] = *(const u32x4*)(yt + (size_t)(c0 + (tid >> 4) + 32 * hf) * M + m0 + 8 * (tid & 15));
#pragma unroll
        for (int hf = 0; hf < 2; ++hf) { const int ch = (tid >> 4) + 32 * hf, pc = tid & 15;
#pragma unroll
            for (int e = 0; e < 8; ++e) { const unsigned w = v[hf][e >> 1]; ty[(8 * pc + e) * 72 + ch] = (unsigned short)((e & 1) ? (w >> 16) : (w & 0xffffu)); } }
        SYNC();
#pragma unroll
        for (int hf = 0; hf < 2; ++hf) { const int r = (tid >> 3) + 64 * hf, cg = tid & 7; *(u32x4*)(Y + (size_t)(m0 + r) * D_MODEL + c0 + 8 * cg) = *(const LAS u32x4*)(ty + r * 72 + 8 * cg); }
        SYNC();
    }
}
static_assert(LB == 128 && LRU_BLOCKS == 8, "lru body geometry");
constexpr int LR_T = 64, LR_NCH = M / LR_T;
#ifdef CPU_EMU
#define LRU_FENCE() ((void)0)
#else
#define LRU_FENCE() asm volatile("" ::: "memory")
#endif
constexpr int LR_XT = 0, LR_HS = 16384, LR_WX = 49152, LR_CW = 53248;
template <int PASS> DEVFN void lru_pass(LAS unsigned char* lds, const bf16* p  , const float* cw  , const float* cbv  , const bf16* lwt,
                                        const float* ba, const float* bx, const float* nsp8  , float* agg  , const float* carry  , bf16* Y, int tid, int bid, int G) {
    const int lane = tid & 63, wave = UNIFORM(tid >> 6), cg = wave & 3, rt = wave >> 2, l31 = lane & 31, h5 = lane >> 5;
    LAS float* Lh = (LAS float*)(lds + LR_HS); LAS float* Lw = (LAS float*)(lds + LR_WX);
    const int n = bid % LRU_BLOCKS, GB = G / LRU_BLOCKS;
    bf16x8 fr[8], fi[8];
#define LRU_LOADW(dir_) do { const bf16* wr_ = lwt + ((size_t)((dir_) * 2 + 0) * LRU_BLOCKS + n) * LB * LB + (size_t)(32 * cg + l31) * LB + 8 * h5; const bf16* wi_ = wr_ + (size_t)LRU_BLOCKS * LB * LB; \
        _Pragma("unroll") for (int ks = 0; ks < 8; ++ks) { fr[ks] = *(const bf16x8*)(wr_ + 16 * ks); fi[ks] = *(const bf16x8*)(wi_ + 16 * ks); } } while (0)
    LRU_LOADW(0);
    float gba[2], gbx[2], gns[2];
#pragma unroll
    for (int dir = 0; dir < 2; ++dir) { const int c = n * LB + 32 * cg + l31; gba[dir] = ba[dir * LW + c]; gbx[dir] = bx[dir * LW + c]; gns[dir] = nsp8[dir * LW + c]; }
    LAS float* Lc = (LAS float*)(lds + LR_CW);
    if (tid < LB) {
#pragma unroll
        for (int j = 0; j < 4; ++j) Lc[j * LB + tid] = cw[j * LW + n * LB + tid];
        Lc[4 * LB + tid] = cbv[n * LB + tid]; }
    u32x4 tap[2][4];
#define LRU_LOADTAPS(chunk_) do { const int m0_ = (chunk_) * LR_T, row0_ = m0_ < BATCH * SEQ ? (m0_ / SEQ) * SEQ : BATCH * SEQ, len_ = m0_ < BATCH * SEQ ? SEQ : DEC_SEQ, t_ = m0_ + (tid >> 3) - row0_; \
        _Pragma("unroll") for (int q = 0; q < 2; ++q) _Pragma("unroll") for (int j = 0; j < 4; ++j) { const int tt = t_ + j - 2; \
            tap[q][j] = (tt >= 0 && tt < len_) ? *(const u32x4*)(p + (size_t)(row0_ + tt) * IN_EVEN + 3 * HW + LW + n * LB + 8 * ((tid & 7) * 2 + q)) : (u32x4){0u, 0u, 0u, 0u}; } } while (0)
    const int chunk0 = bid / LRU_BLOCKS; const bool active = bid < GB * LRU_BLOCKS;
    if (active && chunk0 < LR_NCH) LRU_LOADTAPS(chunk0);
    SYNC();
    for (int chunk = chunk0; chunk < LR_NCH && active; chunk += GB) {
        const int m0 = chunk * LR_T;
        int tid_i = tid; OPAQUE_V(tid_i); const int l31 = tid_i & 31, h5 = (tid_i >> 5) & 1;
        { const int r = tid_i >> 3;
#pragma unroll
          for (int q = 0; q < 2; ++q) { const int ch = (tid_i & 7) * 2 + q; float x[8];
              { const f32x4 b0 = *(const LAS f32x4*)(Lc + 4 * LB + 8 * ch), b1 = *(const LAS f32x4*)(Lc + 4 * LB + 8 * ch + 4);
#pragma unroll
                for (int e = 0; e < 4; ++e) { x[e] = b0[e]; x[4 + e] = b1[e]; } }
#pragma unroll
              for (int j = 0; j < 4; ++j) { const u32x4 v = tap[q][j]; const f32x4 w0 = *(const LAS f32x4*)(Lc + j * LB + 8 * ch), w1 = *(const LAS f32x4*)(Lc + j * LB + 8 * ch + 4);
#pragma unroll
                  for (int e = 0; e < 8; ++e) { const unsigned w = v[e >> 1]; x[e] += bf2f((e & 1) ? (w >> 16) : (w & 0xffffu)) * (e < 4 ? w0[e & 3] : w1[e & 3]); } }
              *(LAS u32x4*)(lds + LR_XT + off_b(r, ch)) = (u32x4){CVTPK(x[0], x[1]), CVTPK(x[2], x[3]), CVTPK(x[4], x[5]), CVTPK(x[6], x[7])}; } }
        if (chunk + GB < LR_NCH) LRU_LOADTAPS(chunk + GB);
        float c0v[2]; u32x4 pgv[2];
        if (PASS == 2) {
#pragma unroll
            for (int dir = 0; dir < 2; ++dir) c0v[dir] = carry[((size_t)dir * LR_NCH + chunk) * LW + n * LB + 32 * cg + l31];
#pragma unroll
            for (int q = 0; q < 2; ++q) pgv[q] = *(const u32x4*)(p + (size_t)(m0 + (tid_i >> 3)) * IN_EVEN + 3 * HW + n * LB + 8 * ((tid_i & 7) * 2 + q)); }
        SYNC();
        const int cl = 32 * cg + l31, c = n * LB + cl;
        float hsum[16];
#pragma unroll
        for (int dir = 0; dir < 2; ++dir) {
            f32x16 av, bv;
#pragma unroll
            for (int r = 0; r < 16; ++r) { av[r] = 0.f; bv[r] = 0.f; }
#pragma unroll
            for (int ks = 0; ks < 8; ++ks) { const bf16x8 xf = *(const LAS bf16x8*)(lds + LR_XT + off_b(32 * rt + l31, 2 * ks + h5)); av = MFMA32(xf, fr[ks], av); bv = MFMA32(xf, fi[ks], bv); }
            LRU_LOADW(dir ^ 1);
            { const float bav = gba[dir], bxv = gbx[dir], nsp = gns[dir];
#pragma unroll
              for (int r = 0; r < 16; ++r) { const int t = 32 * rt + (r & 3) + 8 * (r >> 2) + 4 * h5;
                  const float rr = RCP(1.0f + EXP2(-1.4426950408889634f * (av[r] + bav))), ii = RCP(1.0f + EXP2(-1.4426950408889634f * (bv[r] + bxv)));
                  const float la = nsp * rr, a_ = EXP2(1.4426950408889634f * la);
                  const float xbv = bf2f(*(const LAS unsigned short*)(lds + LR_XT + off_b(t, cl >> 3) + 2 * (cl & 7)));
                  av[r] = a_; bv[r] = sqrtf(fmaxf(1.0f - a_ * a_, 0.f)) * (ii * xbv); } }
            float sP[4], sH[4];
#pragma unroll
            for (int j = 0; j < 4; ++j) { float P = 1.f, H = 0.f;
#pragma unroll
                for (int qq = 0; qq < 4; ++qq) { const int r = 4 * j + (dir ? 3 - qq : qq); H = av[r] * H + bv[r]; P *= av[r]; }
                sP[j] = P; sH[j] = H; }
            float oP[4], oH[4];
#pragma unroll
            for (int j = 0; j < 4; ++j) { oP[j] = bperm_f(((tid_i & 63) ^ 32) << 2, sP[j]); oH[j] = bperm_f(((tid_i & 63) ^ 32) << 2, sH[j]); }
            const bool first = dir ? (h5 == 1) : (h5 == 0);
            float pP[4], pH[4];
#pragma unroll
            for (int j = 0; j < 4; ++j) { const float P1 = first ? sP[j] : oP[j], H1 = first ? sH[j] : oH[j], P2 = first ? oP[j] : sP[j], H2 = first ? oH[j] : sH[j]; pP[j] = P2 * P1; pH[j] = P2 * H1 + H2; }
            float wP = 1.f, wH = 0.f;
#pragma unroll
            for (int jj = 0; jj < 4; ++jj) { const int j = dir ? 3 - jj : jj; wH = pP[j] * wH + pH[j]; wP *= pP[j]; }
            if (h5 == 0) { LAS float* w = Lw + ((dir * 2 + rt) * LB + cl) * 2; w[0] = wP; w[1] = wH; }
            SYNC();
            const LAS float* wo = Lw + ((dir * 2 + (rt ^ 1)) * LB + cl) * 2; const float xP = wo[0], xH = wo[1];
            const bool wfirst = dir ? (rt == 1) : (rt == 0);
            if (PASS == 1) { if (!wfirst && h5 == 0) { float* ag = agg + (((size_t)dir * LR_NCH + chunk) * LW + c) * 2; ag[0] = wP * xP; ag[1] = wP * xH + wH; } }
            else { const float c0 = c0v[dir]; float cj = wfirst ? c0 : xP * c0 + xH;
#pragma unroll
                for (int jj = 0; jj < 4; ++jj) { const int j = dir ? 3 - jj : jj; float h = first ? cj : oP[j] * cj + oH[j];
#pragma unroll
                    for (int qq = 0; qq < 4; ++qq) { const int r = 4 * j + (dir ? 3 - qq : qq); h = av[r] * h + bv[r]; if (dir == 0) hsum[r] = h; else hsum[r] += h; }
                    cj = pP[j] * cj + pH[j]; } }
        }
        if (PASS == 2) {
#pragma unroll
            for (int r = 0; r < 16; ++r) Lh[(32 * rt + (r & 3) + 8 * (r >> 2) + 4 * h5) * LB + cl] = hsum[r];
            SYNC();
            const int r = tid_i >> 3;
#pragma unroll
            for (int q = 0; q < 2; ++q) { const int ch = (tid_i & 7) * 2 + q, c = n * LB + 8 * ch; const u32x4 v = pgv[q]; float y[8];
#pragma unroll
                for (int e = 0; e < 8; ++e) { const unsigned w = v[e >> 1]; const float xg = bf2f((e & 1) ? (w >> 16) : (w & 0xffffu)), ug = 0.7978845608028654f * (xg + 0.044715f * xg * xg * xg);
                    y[e] = Lh[r * LB + 8 * ch + e] * xg * RCP(1.0f + EXP2(-2.0f * 1.4426950408889634f * ug)); }
                *(u32x4*)(Y + (size_t)(m0 + r) * D_MODEL + HW + c) = (u32x4){CVTPK(y[0], y[1]), CVTPK(y[2], y[3]), CVTPK(y[4], y[5]), CVTPK(y[6], y[7])}; }
        }
    }
    SYNC();
#undef LRU_LOADW
#undef LRU_LOADTAPS
}
DEVFN void lru_carry_item(const float* agg, float* carry, int item) {
    const int c = item % LW, sq = (item / LW) % (BATCH + 1), dir = item / (LW * (BATCH + 1));
    const int ch0 = (sq < BATCH ? sq * SEQ : BATCH * SEQ) / LR_T, nch = (sq < BATCH ? SEQ : DEC_SEQ) / LR_T;
    float h = 0.f;
    for (int kb = 0; kb < nch; kb += 8) { float pa[8], pb[8];
#pragma unroll
        for (int k = 0; k < 8; ++k) { const int ch = ch0 + (dir ? nch - 1 - (kb + k) : kb + k); const float* ag = agg + (((size_t)dir * LR_NCH + ch) * LW + c) * 2; pa[k] = ag[0]; pb[k] = ag[1]; }
#pragma unroll
        for (int k = 0; k < 8; ++k) { const int ch = ch0 + (dir ? nch - 1 - (kb + k) : kb + k); carry[((size_t)dir * LR_NCH + ch) * LW + c] = h; h = pa[k] * h + pb[k]; } }
}
static_assert(SEQ % 64 == 0 && DEC_SEQ % 64 == 0 && HW % 64 == 0, "filter expansion geometry");
#ifdef CPU_EMU
#define FX_FENCE() ((void)0)
#else
#define FX_FENCE() asm volatile("" ::: "memory")
#endif
constexpr int FX_LS = 80;
constexpr int FX_CD = (HW / 64) * 2, FX_PT = FILT_T / 64, FX_UNITS = N_EVEN * FX_CD * FX_PT;
DEVFN void filter_expand_phase(LAS unsigned char* lds, const float* h2all  , const float* woutall  , bf16* fl0, bf16* fl1  , int tid, int bid, int G) {
    const int cl = tid & 63, tg = UNIFORM(tid >> 6);
    LAS unsigned short* tile = (LAS unsigned short*)lds;
    LAS float* hs = (LAS float*)(lds + 16384);
    LAS float* wsm = (LAS float*)(lds + 16384 + 64 * FX_LS * 4);
    int wkey = -1;
    f32x4 hv[2];
#define FX_LOADH(un_) do { const int cd_ = (un_) % FX_CD, pt_ = (un_) / FX_CD, jj_ = pt_ / FX_PT, ttb_ = pt_ % FX_PT; const bool big_ = ttb_ >= SEQ / 64; \
        const int L_ = big_ ? DEC_SEQ : SEQ, base_ = big_ ? SEQ : 0, pos0_ = (big_ ? ttb_ - SEQ / 64 : ttb_) * 64 + (cd_ & 1); \
        _Pragma("unroll") for (int r = 0; r < 2; ++r) { const int idx = tid + 512 * r, pos = pos0_ + (idx >> 4); \
            hv[r] = *(const f32x4*)(h2all + (size_t)jj_ * FILT_T * FO + (size_t)(base_ + (pos < L_ ? pos : L_ - 1)) * FO + 4 * (idx & 15)); } } while (0)
    if (bid < FX_UNITS) FX_LOADH(bid);
    for (int un = bid; un < FX_UNITS; un += G) {
        const int cd = un % FX_CD, pt = un / FX_CD, jj = pt / FX_PT, ttb = pt % FX_PT, dir = cd & 1, c0 = (cd >> 1) * 64;
        const bool big = ttb >= SEQ / 64; const int L = big ? DEC_SEQ : SEQ, pos0 = (big ? ttb - SEQ / 64 : ttb) * 64 + dir;
        if (wkey != jj * FX_CD + cd) { wkey = jj * FX_CD + cd; const float* wt = woutall + (size_t)jj * FO * 2 * HW + dir * HW + c0;
#pragma unroll
            for (int r = 0; r < 8; ++r) { const int idx = tid + 512 * r, q = idx >> 6, c = idx & 63; wsm[q * FX_LS + c] = wt[(size_t)q * 2 * HW + c]; } }
#pragma unroll
        for (int r = 0; r < 2; ++r) { const int idx = tid + 512 * r, pi = idx >> 4, q4 = idx & 15; const f32x4 v = hv[r];
            hs[(4 * q4 + 0) * FX_LS + pi] = v[0]; hs[(4 * q4 + 1) * FX_LS + pi] = v[1]; hs[(4 * q4 + 2) * FX_LS + pi] = v[2]; hs[(4 * q4 + 3) * FX_LS + pi] = v[3]; }
        if (un + G < FX_UNITS) FX_LOADH(un + G);
        SYNC();
        { const int lane = tid & 63, l15 = lane & 15, l4 = lane >> 4, cb = tg & 3, pbw = tg >> 2;
          f32x4 acc[2] = {{0.f, 0.f, 0.f, 0.f}, {0.f, 0.f, 0.f, 0.f}};
          const LAS float* hp = hs + l4 * FX_LS + 32 * pbw + l15; const LAS float* wp = wsm + l4 * FX_LS + 16 * cb + l15;
#pragma unroll 4
          for (int ks = 0; ks < FO / 4; ++ks) { const float b = wp[4 * ks * FX_LS], a0 = hp[4 * ks * FX_LS], a1 = hp[4 * ks * FX_LS + 16];
              acc[0] = MFMA16F32(a0, b, acc[0]); acc[1] = MFMA16F32(a1, b, acc[1]); }
          const int chl = 16 * cb + l15;
          const float la = -4.605170185988091f / 1.5f, lb = -4.605170185988091f / 0.3f;
          const float delta = fabsf(la + (lb - la) * (float)(c0 + chl) / (float)(HW - 1)), inv = 1.0f / (float)(L - 1 > 1 ? L - 1 : 1);
#pragma unroll
          for (int sb = 0; sb < 2; ++sb) { const int posl = 32 * pbw + 16 * sb + 4 * l4; unsigned short e[4];
#pragma unroll
              for (int r = 0; r < 4; ++r) { const int pos = pos0 + posl + r; e[r] = (unsigned short)f2bf(pos < L ? acc[sb][r] * expf(-((float)pos * inv) * delta) : 0.f); }
              *(LAS unsigned*)(tile + chl * 72 + posl) = (unsigned)e[0] | ((unsigned)e[1] << 16); *(LAS unsigned*)(tile + chl * 72 + posl + 2) = (unsigned)e[2] | ((unsigned)e[3] << 16); } }
        SYNC();
        { const int c = tid >> 3, pc = tid & 7; bf16* fl = jj ? fl1 : fl0; bf16* f = big ? fl + (size_t)(c0 + c) * 2 * DEC_SEQ : fl + (size_t)HW * 2 * DEC_SEQ + (size_t)(c0 + c) * 2 * SEQ;
          unsigned short e[8];
          if (dir == 0) {
#pragma unroll
              for (int i = 0; i < 8; ++i) e[i] = tile[c * 72 + 63 - 8 * pc - i];
              *(u32x4*)(f + L - 64 - pos0 + 8 * pc) = (u32x4){(unsigned)e[0] | ((unsigned)e[1] << 16), (unsigned)e[2] | ((unsigned)e[3] << 16), (unsigned)e[4] | ((unsigned)e[5] << 16), (unsigned)e[6] | ((unsigned)e[7] << 16)};
          } else {
#pragma unroll
              for (int i = 0; i < 8; ++i) e[i] = tile[c * 72 + 8 * pc + i];
              *(u32x4*)(f + L - 1 + pos0 + 8 * pc) = (u32x4){(unsigned)e[0] | ((unsigned)e[1] << 16), (unsigned)e[2] | ((unsigned)e[3] << 16), (unsigned)e[4] | ((unsigned)e[5] << 16), (unsigned)e[6] | ((unsigned)e[7] << 16)};
          } }
        SYNC();
    }
#undef FX_LOADH
}
namespace pg8 {
struct EpiQKVRopeWs {
    static constexpr bool PERM = true, AFTER_DRAIN = false;
    unsigned char* ws; int ninst, jodd;
    __device__ __forceinline__ void operator()(const f32x4 (&acc)[2][2][4][2], const Unit& u, int wr, int wc, int fr, int fq) const {
        const EpiQKVRope e{(bf16_t*)(ws + WS_G), QKV_N, (const pg8::rowss_t*)(ws + WS_ROWSS) + (size_t)ninst * M, (const float*)(ws + WS_ROPE), 0.125f * 1.4426950408889634f, (unsigned*)(ws + WS_KMAX) + (size_t)jodd * KMAX_LAYER};
        e(acc, u, wr, wc, fr, fq);
    }
};
}
__device__ __forceinline__ int probe_reps(int n) { asm volatile("" : "+s"(n)); return n; }
__global__ void __launch_bounds__(NTHREADS, 2) enc_fwd(Args args) {
    extern __shared__ __attribute__((aligned(16))) unsigned char lds[];
    LAS unsigned char* const L = (LAS unsigned char*)lds;
    volatile LAS unsigned* MISC = (volatile LAS unsigned*)(L + MISC_OFF);
    for (int u = threadIdx.x; u < (LDS_BYTES - LDSCTL_OFF) / 4; u += NTHREADS) ((LAS unsigned*)(L + LDSCTL_OFF))[u] = 0u;
    __syncthreads();
    XcdBarrier bar = xcd_barrier_post((unsigned*)(args.ws + WS_CTL) + CW_BAR, MISC + 8);
    const int lo = args.ph_lo, hi = args.ph_hi;
    const int wave0 = __builtin_amdgcn_readfirstlane((int)threadIdx.x >> 6);
#define PHASE(k) if (lo <= (k) && (k) < hi)
#define ENTER() const Frame F = make_frame(L, wave0); const CArgs* const ap = opaque_args(); const CArgs& A = *ap; unsigned char* const ws = A.ws; float* const X = A.out; \
    bf16* const H = (bf16*)(ws + WS_H); bf16* const Gb = (bf16*)(ws + WS_G); bf16* const Y = (bf16*)(ws + WS_Y); (void)F; (void)X; (void)H; (void)Gb; (void)Y
#define SEAM(k) do { if ((k) + 1 < hi) xcd_barrier(bar); } while (0)
#ifdef PROBE_TAG
#define REP(tag) for (int rep_ = 0, nrep_ = (PROBE_TAG == (tag)) ? probe_reps(2) : 1; rep_ < nrep_; ++rep_)
#else
#define REP(tag)
#endif

    PHASE(PH_PRO0) { ENTER(); REP(1) phase_prologue0(F, A); SEAM(PH_PRO0); }
    PHASE(PH_PRO1) { ENTER(); REP(14) phase_filter_hidden(F, A, 0); SEAM(PH_PRO1); }
    PHASE(PH_PRO2) { ENTER(); phase_filter_hidden(F, A, 1); SEAM(PH_PRO2); }
    PHASE(PH_PRO3) { ENTER();
        REP(13) filter_expand_phase(F.lds + RING_OFF, (const float*)(ws + WS_FH) + (size_t)2 * N_EVEN * FILT_T * FO, A.in[15], (bf16*)(ws + ws_filt(0)), (bf16*)(ws + ws_filt(1)), F.tid, F.bid, F.G);
        SEAM(PH_PRO3); }

    for (int l = 0; l < DEPTH; ++l) {
        const int pb = PH_LAYER0 + l * PH_PER_LAYER, j = l >> 1;
        PHASE(pb + 1) { ENTER(); const pg8::rowss_t* rss = (const pg8::rowss_t*)(ws + WS_ROWSS) + (size_t)(3 * l + 0) * M; pg8::Gemm g{H, (const bf16*)(ws + WS_WUP + (size_t)(l * 2 + 0) * UP_BYTES), M, UP_N, D_MODEL}; pg8::StaticOrder S; S.init(M, UP_N, F.G, F.bid);
            pg8::EpiSwiGLUNorm E{Gb, D_FF, rss}; REP(2) pg8::gemm_phase<pg8::EpiSwiGLUNorm, pg8::StaticOrder, true, true>(F.lds + RING_OFF, g, S, E, F.tid); SEAM(pb + 1); }
        PHASE(pb + 2) { ENTER(); pg8::Gemm g{Gb, (const bf16*)(ws + WS_WDN + (size_t)(l * 2 + 0) * DN_BYTES), M, D_MODEL, D_FF}; pg8::StaticOrder S; S.init(M, D_MODEL, F.G, F.bid);
            pg8::EpiResidNorm E{X, H, (pg8::rowss_t*)(ws + WS_ROWSS) + (size_t)(3 * l + 1) * M, D_MODEL, 0.5f}; pg8::gemm_phase<pg8::EpiResidNorm, pg8::StaticOrder, false, true, true, false>(F.lds + RING_OFF, g, S, E, F.tid); SEAM(pb + 2); }
        if (!(l & 1)) {
            PHASE(pb + 4) { ENTER(); pg8::Gemm g{H, (const bf16*)(ws + WS_WEIN + (size_t)j * EIN_BYTES), M, IN_EVEN, D_MODEL}; pg8::StaticOrder S; S.init(M, IN_EVEN, F.G, F.bid);
                pg8::EpiBf16Norm E{Gb, IN_EVEN, (const pg8::rowss_t*)(ws + WS_ROWSS) + (size_t)(3 * l + 1) * M}; REP(10) pg8::gemm_phase<pg8::EpiBf16Norm, pg8::StaticOrder, true, true>(F.lds + RING_OFF, g, S, E, F.tid); SEAM(pb + 4); }
            PHASE(pb + 5) { ENTER();
                REP(9) hyena_pre_phase(F.lds + RING_OFF, Gb, A.in[9] + (size_t)j * 9 * HW, A.in[10] + (size_t)j * 3 * HW, (bf16*)(ws + WS_UT), (bf16*)(ws + WS_X0T), F.tid, F.bid, F.G);
                REP(8) lru_pass<1>(F.lds + RING_OFF, Gb, A.in[17] + (size_t)j * 4 * LW, A.in[18] + (size_t)j * LW, (const bf16*)(ws + WS_LWT) + (size_t)j * LWT_LAYER,
                            A.in[20] + (size_t)j * 2 * LW, A.in[22] + (size_t)j * 2 * LW, (const float*)(ws + WS_NSP) + (size_t)j * 2 * LW, (float*)(ws + WS_AGG), (const float*)(ws + WS_CARRY), Y, F.tid, F.bid, F.G);
                SEAM(pb + 5); }
            PHASE(pb + 6) { ENTER();
                for (int i = F.gtid; i < 2 * (BATCH + 1) * LW; i += F.gsize) lru_carry_item((const float*)(ws + WS_AGG), (float*)(ws + WS_CARRY), i);
                REP(4) hyena_conv_phase(F.lds + RING_OFF, (const bf16*)(ws + ws_filt(j)), (const bf16*)(ws + ws_filt(j) + F8_BYTES), (const bf16*)(ws + WS_UT), (const bf16*)(ws + WS_X0T), (bf16*)(ws + WS_YT), A.in[16] + (size_t)j * HW, F.tid, F.bid, F.G);
                SEAM(pb + 6); }
            PHASE(pb + 7) { ENTER();
                REP(11) lru_pass<2>(F.lds + RING_OFF, Gb, A.in[17] + (size_t)j * 4 * LW, A.in[18] + (size_t)j * LW, (const bf16*)(ws + WS_LWT) + (size_t)j * LWT_LAYER,
                            A.in[20] + (size_t)j * 2 * LW, A.in[22] + (size_t)j * 2 * LW, (const float*)(ws + WS_NSP) + (size_t)j * 2 * LW, (float*)(ws + WS_AGG), (const float*)(ws + WS_CARRY), Y, F.tid, F.bid, F.G);
                REP(12) hyena_post_phase(F.lds + RING_OFF, (const bf16*)(ws + WS_YT), Y, F.tid, F.bid, F.G);
                SEAM(pb + 7); }
            PHASE(pb + 11) { ENTER(); pg8::Gemm g{Y, (const bf16*)(ws + WS_WEOUT + (size_t)j * SQ_BYTES), M, D_MODEL, D_MODEL}; pg8::StaticOrder S; S.init(M, D_MODEL, F.G, F.bid);
                pg8::EpiResidNorm E{X, H, (pg8::rowss_t*)(ws + WS_ROWSS) + (size_t)(3 * l + 2) * M, D_MODEL, 1.0f}; pg8::gemm_phase<pg8::EpiResidNorm, pg8::StaticOrder, false, true>(F.lds + RING_OFF, g, S, E, F.tid); SEAM(pb + 11); }
        } else {
            PHASE(pb + 4) { ENTER(); pg8::Gemm g{H, (const bf16*)(ws + WS_WQKV + (size_t)j * QKVW_BYTES), M, QKV_N, D_MODEL}; pg8::StaticOrder S; S.init(M, QKV_N, F.G, F.bid);
                pg8::EpiQKVRopeWs E{ws, 3 * l + 1, j}; REP(10) pg8::gemm_phase<pg8::EpiQKVRopeWs, pg8::StaticOrder, true, true>(F.lds + RING_OFF, g, S, E, F.tid); SEAM(pb + 4); }
            PHASE(pb + 6) { ENTER();
                const float lam = attn_lambda_of(A.in[26] + (size_t)j * 4 * DH, l), omli = 1.0f - lambda_init_of(l);
                REP(3) attn_phase(F.lds + RING_OFF, Gb, Y, A.in[27] + (size_t)j * DV, (const unsigned*)(ws + WS_KMAX) + (size_t)j * KMAX_LAYER, lam, omli, F.tid, F.bid, F.G);
                SEAM(pb + 6); }
            PHASE(pb + 11) { ENTER(); pg8::Gemm g{Y, (const bf16*)(ws + WS_WWO + (size_t)j * SQ_BYTES), M, D_MODEL, D_MODEL}; pg8::StaticOrder S; S.init(M, D_MODEL, F.G, F.bid);
                pg8::EpiResidNorm E{X, H, (pg8::rowss_t*)(ws + WS_ROWSS) + (size_t)(3 * l + 2) * M, D_MODEL, 1.0f}; pg8::gemm_phase<pg8::EpiResidNorm, pg8::StaticOrder, false, true>(F.lds + RING_OFF, g, S, E, F.tid); SEAM(pb + 11); }
        }
        PHASE(pb + 13) { ENTER(); const pg8::rowss_t* rss = (const pg8::rowss_t*)(ws + WS_ROWSS) + (size_t)(3 * l + 2) * M; pg8::Gemm g{H, (const bf16*)(ws + WS_WUP + (size_t)(l * 2 + 1) * UP_BYTES), M, UP_N, D_MODEL}; pg8::StaticOrder S; S.init(M, UP_N, F.G, F.bid);
            pg8::EpiSwiGLUNorm E{Gb, D_FF, rss}; REP(2) pg8::gemm_phase<pg8::EpiSwiGLUNorm, pg8::StaticOrder, true, true>(F.lds + RING_OFF, g, S, E, F.tid); SEAM(pb + 13); }
        PHASE(pb + 14) { ENTER(); pg8::Gemm g{Gb, (const bf16*)(ws + WS_WDN + (size_t)(l * 2 + 1) * DN_BYTES), M, D_MODEL, D_FF}; pg8::StaticOrder S; S.init(M, D_MODEL, F.G, F.bid);
            pg8::EpiResidNorm E{X, H, (pg8::rowss_t*)(ws + WS_ROWSS) + (size_t)(3 * l + 3) * M, D_MODEL, 0.5f}; pg8::gemm_phase<pg8::EpiResidNorm, pg8::StaticOrder, false, true, true, false>(F.lds + RING_OFF, g, S, E, F.tid); SEAM(pb + 14); }
    }
    PHASE(PH_FINAL) { ENTER();
        const pg8::rowss_t* rss = (const pg8::rowss_t*)(ws + WS_ROWSS) + (size_t)(3 * DEPTH) * M; const f32x4* gr = (const f32x4*)A.in[7];
        for (int m = F.gw; m < M; m += F.ngw) { const float rs = 1.0f / sqrtf((float)rss[m] * (1.0f / (pg8::ROWSS_SCALE * D_MODEL)) + NORM_EPS);
            f32x4* xp = (f32x4*)(X + (size_t)m * D_MODEL) + F.lane; f32x4 v[8], gg[8];
#pragma unroll
            for (int j = 0; j < 8; ++j) { v[j] = xp[64 * j]; gg[j] = gr[F.lane + 64 * j]; }
#pragma unroll
            for (int j = 0; j < 8; ++j) xp[64 * j] = (f32x4){v[j].x * rs * gg[j].x, v[j].y * rs * gg[j].y, v[j].z * rs * gg[j].z, v[j].w * rs * gg[j].w}; } }
#undef PHASE
#undef ENTER
#undef SEAM
}

#ifndef MK_PER_PHASE
#define MK_PER_PHASE 0
#endif
extern "C" void kernel_launch(void* const* d_in, const int* in_sizes, int n_in, void* d_out, int out_size, void* d_ws, size_t ws_size, hipStream_t stream) {
    static int grid = 0;
    if (grid == 0) {
        if (n_in != 29 || out_size != M * D_MODEL || ws_size < WS_END) { fprintf(stderr, "kernel_launch: built for 29 inputs, %d outputs, >= %zu bytes of workspace; got n_in %d, out %d, ws %zu; nothing launched\n", M * D_MODEL, (size_t)WS_END, n_in, out_size, ws_size); grid = -1; return; }
        int dev = 0, cus = 0, per_cu = 0;
        if (hipGetDevice(&dev) != hipSuccess || hipDeviceGetAttribute(&cus, hipDeviceAttributeMultiprocessorCount, dev) != hipSuccess) { grid = -1; return; }
        if (hipFuncSetAttribute((const void*)enc_fwd, hipFuncAttributeMaxDynamicSharedMemorySize, LDS_BYTES) != hipSuccess) { fprintf(stderr, "kernel_launch: hipFuncSetAttribute failed\n"); grid = -1; return; }
        if (hipOccupancyMaxActiveBlocksPerMultiprocessor(&per_cu, (const void*)enc_fwd, NTHREADS, LDS_BYTES) != hipSuccess || per_cu < 1) fprintf(stderr, "kernel_launch: occupancy query reports %d workgroups per CU\n", per_cu);
        (void)hipGetLastError();
        grid = cus;
    }
    if (grid < 0) return;
    if (hipMemsetAsync((char*)d_ws + WS_CTL, 0, ZERO_BYTES, stream) != hipSuccess) return;
    Args a{};
    for (int i = 0; i < 29; ++i) a.in[i] = (const float*)d_in[i];
    a.out = (float*)d_out; a.ws = (unsigned char*)d_ws;
#if MK_PER_PHASE
    for (int k = 0; k < NPHASES; ++k) { if (!phase_exists(k)) continue; a.ph_lo = k; a.ph_hi = k + 1; hipLaunchKernelGGL(enc_fwd, dim3(grid), dim3(NTHREADS), LDS_BYTES, stream, a); }
#else
    a.ph_lo = 0; a.ph_hi = NPHASES; hipLaunchKernelGGL(enc_fwd, dim3(grid), dim3(NTHREADS), LDS_BYTES, stream, a);
#endif
}
#endif
```
